# Optimizing an MI355X kernel written in HIP

```python
import math
import jax, jax.numpy as jnp
from jax import lax
import numpy as np

D_MODEL = 1024
BATCH = 8
SEQ = 8192
DEPTH = 4

HEAD_DIM = 64
N_HEADS_TOTAL = D_MODEL // HEAD_DIM
N_HEADS_A = N_HEADS_TOTAL // 2
N_HEADS_B = N_HEADS_TOTAL // 4
N_HEADS_C = N_HEADS_TOTAL - N_HEADS_A - N_HEADS_B
DIFF_HALF = HEAD_DIM // 2
WIDTH_A = N_HEADS_A * HEAD_DIM
WIDTH_B = N_HEADS_B * HEAD_DIM
WIDTH_C = N_HEADS_C * HEAD_DIM
MIX_WIDTH = WIDTH_A + WIDTH_B + WIDTH_C
SPLITS = [int(c) for c in np.cumsum([WIDTH_A] * 3 + [WIDTH_B] * 3 + [WIDTH_C] * 2)]
D_FF = D_MODEL
DILATED_BRANCHES = ((128, 1), (512, 4), (2048, 16))
Q_BLOCK = 128
N_BUCKETS = 32
MAX_DISTANCE = 2048
N_BIAS_HEADS = N_HEADS_A + N_HEADS_B
EPS = 1e-6
NEG_INF = -1e30
SB_MASK = 1e4

kernel_name = 'hybrid_dilated_diff_stickbreak_macaron'


def rms_norm(x, gain):
    xf = x.astype(jnp.float32)
    y = xf * lax.rsqrt(jnp.mean(xf * xf, axis=-1, keepdims=True) + EPS)
    return (y * gain.astype(jnp.float32)).astype(x.dtype)


def swiglu(x, w_gate, w_up, w_down):
    return (jax.nn.silu(x @ w_gate) * (x @ w_up)) @ w_down


def t5_bucket(dist):
    dist = jnp.maximum(dist, 0)
    max_exact = N_BUCKETS // 2
    d_f = jnp.maximum(dist, 1).astype(jnp.float32)
    large = max_exact + (jnp.log(d_f / max_exact) / math.log(MAX_DISTANCE / max_exact)
                         * (N_BUCKETS - max_exact)).astype(jnp.int32)
    large = jnp.minimum(large, N_BUCKETS - 1)
    return jnp.where(dist < max_exact, dist, large)


def split_heads(t, n_heads, dh):
    b, s, _ = t.shape
    return t.reshape(b, s, n_heads, dh).transpose(0, 2, 1, 3)


def merge_heads(t):
    b, h, s, dh = t.shape
    return t.transpose(0, 2, 1, 3).reshape(b, s, h * dh)


def dilated_bias_masks(bias_a, seq):
    out = []
    i = jnp.arange(Q_BLOCK, dtype=jnp.int32)[:, None]
    j = jnp.arange(2 * Q_BLOCK, dtype=jnp.int32)[None, :]
    for window, dil in DILATED_BRANCHES:
        n = window // dil
        nb = -(-(seq // dil) // Q_BLOCK)
        off = i + n - j
        blk = jnp.arange(nb, dtype=jnp.int32)[:, None, None]
        valid = (off >= 0) & (off <= n) & (blk * Q_BLOCK - n + j >= 0)
        bias = jnp.moveaxis(jnp.take(bias_a, t5_bucket(off * dil), axis=0), -1, 0)
        out.append(jnp.where(valid[None], bias[:, None], NEG_INF))
    return out


def dilated_attention(q, k, v, bias_masks):
    b, h, s, dh = q.shape
    outs, lses = [], []
    for (window, dil), bm in zip(DILATED_BRANCHES, bias_masks):
        n = window // dil
        length = s // dil
        nb = bm.shape[1]
        padl = nb * Q_BLOCK

        def sub(t):
            return t.reshape(b, h, length, dil, dh).transpose(0, 1, 3, 2, 4)

        def band(t):
            tp = jnp.pad(sub(t), ((0, 0), (0, 0), (0, 0), (n, padl - length), (0, 0)))
            tp = tp.reshape(b, h, dil, nb + 1, Q_BLOCK, dh)
            return jnp.concatenate([tp[:, :, :, :-1], tp[:, :, :, 1:]], axis=4)

        qs = jnp.pad(sub(q), ((0, 0), (0, 0), (0, 0), (0, padl - length), (0, 0)))
        qs = qs.reshape(b, h, dil, nb, Q_BLOCK, dh)
        logits = jnp.einsum('bhrnqd,bhrnkd->bhrnqk', qs, band(k)) + bm[None, :, None]
        lse = jax.nn.logsumexp(logits, axis=-1)
        o = jnp.einsum('bhrnqk,bhrnkd->bhrnqd', jnp.exp(logits - lse[..., None]), band(v))
        o = o.reshape(b, h, dil, padl, dh)[:, :, :, :length].transpose(0, 1, 3, 2, 4)
        lse = lse.reshape(b, h, dil, padl)[..., :length].transpose(0, 1, 3, 2)
        outs.append(o.reshape(b, h, s, dh))
        lses.append(lse.reshape(b, h, s))
    wts = jax.nn.softmax(jnp.stack(lses), axis=0)
    return jnp.sum(wts[..., None] * jnp.stack(outs), axis=0)


def diff_attention(q, k, v, lam, dist_bias):
    s = q.shape[3]
    outs = []
    for i in range(s // Q_BLOCK):
        t0, kl = i * Q_BLOCK, (i + 1) * Q_BLOCK
        tq = t0 + jnp.arange(Q_BLOCK, dtype=jnp.int32)
        dist = tq[:, None] - jnp.arange(kl, dtype=jnp.int32)[None, :]
        bias = jnp.where(dist >= 0, jnp.take(dist_bias, jnp.maximum(dist, 0), axis=1), NEG_INF)
        logits = jnp.einsum('bhmqd,bhmkd->bhmqk', q[:, :, :, t0:kl], k[:, :, :, :kl]) + bias[:, None]
        e = jnp.exp(logits - jnp.max(logits, axis=-1, keepdims=True))
        pv = jnp.einsum('bhmqk,bhkd->bhmqd', e, v[:, :, :kl]) / jnp.sum(e, axis=-1)[..., None]
        outs.append(pv[:, :, 0] - lam * pv[:, :, 1])
    return jnp.concatenate(outs, axis=2)


def stick_breaking_attention(q, k, v):
    b, h, s, dh = q.shape
    ar = jnp.arange(Q_BLOCK, dtype=jnp.int32)
    incl = (ar[:, None] >= ar[None, :]).astype(q.dtype)
    outs = []
    for i in range(s // Q_BLOCK):
        t0, nk = i * Q_BLOCK, i + 1
        kl = nk * Q_BLOCK
        tq = t0 + ar
        strict = jnp.arange(kl, dtype=jnp.int32)[None, :] < tq[:, None]
        z = jnp.where(strict, jnp.einsum('bhqd,bhkd->bhqk', q[:, :, t0:kl], k[:, :, :kl]), -SB_MASK)
        lnot = (-jax.nn.softplus(z)).reshape(b, h, Q_BLOCK, nk, Q_BLOCK)
        within = jnp.einsum('bhqnj,js->bhqns', lnot, incl)
        later = (jnp.arange(nk)[:, None] > jnp.arange(nk)[None, :]).astype(q.dtype)
        carry = jnp.einsum('bhqn,nm->bhqm', jnp.sum(lnot, axis=-1), later)
        log_a = z + (within + carry[..., None]).reshape(b, h, Q_BLOCK, kl)
        outs.append(jnp.einsum('bhqk,bhkd->bhqd', jnp.exp(log_a), v[:, :, :kl]))
    return jnp.concatenate(outs, axis=2)


def token_mix(h, w_in, w_out, q_norm_a, k_norm_a, q_norm_b, k_norm_b,
              lambda_q1, lambda_k1, lambda_q2, lambda_k2, diff_subln, a_masks, b_dist_bias, layer):
    b, s, _ = h.shape
    proj = (h @ w_in).astype(jnp.float32)
    qa, ka, va, qb, kb, vb, qc, kc, vc = jnp.split(proj, SPLITS, axis=-1)

    qa = rms_norm(split_heads(qa, N_HEADS_A, HEAD_DIM), q_norm_a) * (HEAD_DIM ** -0.5)
    ka = rms_norm(split_heads(ka, N_HEADS_A, HEAD_DIM), k_norm_a)
    out_a = dilated_attention(qa, ka, split_heads(va, N_HEADS_A, HEAD_DIM), a_masks)

    def two_maps(t, g):
        t = split_heads(t, N_HEADS_B, HEAD_DIM).reshape(b, N_HEADS_B, s, 2, DIFF_HALF)
        return rms_norm(t, g).transpose(0, 1, 3, 2, 4)
    lam_init = 0.8 - 0.6 * math.exp(-0.3 * layer)
    lam = (jnp.exp(jnp.sum(lambda_q1.astype(jnp.float32) * lambda_k1.astype(jnp.float32)))
           - jnp.exp(jnp.sum(lambda_q2.astype(jnp.float32) * lambda_k2.astype(jnp.float32)))
           + lam_init)
    out_b = diff_attention(two_maps(qb, q_norm_b) * (DIFF_HALF ** -0.5), two_maps(kb, k_norm_b),
                           split_heads(vb, N_HEADS_B, HEAD_DIM), lam, b_dist_bias)
    out_b = rms_norm(out_b, diff_subln) * (1.0 - lam_init)

    out_c = stick_breaking_attention(split_heads(qc, N_HEADS_C, HEAD_DIM) * (HEAD_DIM ** -0.5),
                                     split_heads(kc, N_HEADS_C, HEAD_DIM),
                                     split_heads(vc, N_HEADS_C, HEAD_DIM))

    mixed = jnp.concatenate([merge_heads(out_a), merge_heads(out_b), merge_heads(out_c)], axis=-1)
    return mixed.astype(h.dtype) @ w_out


def setup_inputs(seed: int = 0) -> dict:
    key = jax.random.key(seed)
    ks = jax.random.split(key, 22)
    f32 = jnp.float32

    def nrm(k, shape, scale):
        return scale * jax.random.normal(k, shape, f32)

    def gain(k, shape):
        return 1.0 + 0.01 * jax.random.normal(k, shape, f32)

    return {
        'x': nrm(ks[0], (BATCH, SEQ, D_MODEL), 1.0),
        'rel_bias': nrm(ks[1], (N_BUCKETS, N_BIAS_HEADS), 0.5),
        'ffn1_norm': gain(ks[2], (DEPTH, D_MODEL)),
        'ffn1_w_gate': nrm(ks[3], (DEPTH, D_MODEL, D_FF), D_MODEL ** -0.5),
        'ffn1_w_up': nrm(ks[4], (DEPTH, D_MODEL, D_FF), D_MODEL ** -0.5),
        'ffn1_w_down': nrm(ks[5], (DEPTH, D_FF, D_MODEL), D_FF ** -0.5),
        'mix_norm': gain(ks[6], (DEPTH, D_MODEL)),
        'w_in': nrm(ks[7], (DEPTH, D_MODEL, 3 * MIX_WIDTH), D_MODEL ** -0.5),
        'q_norm_a': gain(ks[8], (DEPTH, HEAD_DIM)),
        'k_norm_a': gain(ks[9], (DEPTH, HEAD_DIM)),
        'q_norm_b': gain(ks[10], (DEPTH, DIFF_HALF)),
        'k_norm_b': gain(ks[11], (DEPTH, DIFF_HALF)),
        'lambda_q1': nrm(ks[12], (DEPTH, DIFF_HALF), 0.1),
        'lambda_k1': nrm(ks[13], (DEPTH, DIFF_HALF), 0.1),
        'lambda_q2': nrm(ks[14], (DEPTH, DIFF_HALF), 0.1),
        'lambda_k2': nrm(ks[15], (DEPTH, DIFF_HALF), 0.1),
        'diff_subln': gain(ks[16], (DEPTH, HEAD_DIM)),
        'w_out': nrm(ks[17], (DEPTH, MIX_WIDTH, D_MODEL), MIX_WIDTH ** -0.5),
        'ffn2_norm': gain(ks[18], (DEPTH, D_MODEL)),
        'ffn2_w_gate': nrm(ks[19], (DEPTH, D_MODEL, D_FF), D_MODEL ** -0.5),
        'ffn2_w_up': nrm(ks[20], (DEPTH, D_MODEL, D_FF), D_MODEL ** -0.5),
        'ffn2_w_down': nrm(ks[21], (DEPTH, D_FF, D_MODEL), D_FF ** -0.5),
    }


def reference(x, rel_bias, ffn1_norm, ffn1_w_gate, ffn1_w_up, ffn1_w_down, mix_norm, w_in,
              q_norm_a, k_norm_a, q_norm_b, k_norm_b, lambda_q1, lambda_k1, lambda_q2, lambda_k2,
              diff_subln, w_out, ffn2_norm, ffn2_w_gate, ffn2_w_up, ffn2_w_down):
    seq = x.shape[1]
    rb = rel_bias.astype(jnp.float32)
    a_masks = dilated_bias_masks(rb[:, :N_HEADS_A], seq)
    b_dist_bias = jnp.take(rb[:, N_HEADS_A:], t5_bucket(jnp.arange(seq, dtype=jnp.int32)), axis=0).T
    for layer in range(DEPTH):
        h = rms_norm(x, ffn1_norm[layer])
        x = x + 0.5 * swiglu(h, ffn1_w_gate[layer], ffn1_w_up[layer], ffn1_w_down[layer])
        h = rms_norm(x, mix_norm[layer])
        x = x + token_mix(h, w_in[layer], w_out[layer], q_norm_a[layer], k_norm_a[layer],
                          q_norm_b[layer], k_norm_b[layer], lambda_q1[layer], lambda_k1[layer],
                          lambda_q2[layer], lambda_k2[layer], diff_subln[layer],
                          a_masks, b_dist_bias, layer)
        h = rms_norm(x, ffn2_norm[layer])
        x = x + 0.5 * swiglu(h, ffn2_w_gate[layer], ffn2_w_up[layer], ffn2_w_down[layer])
    return x
```

```cpp
#include <hip/hip_runtime.h>
#include <hip/hip_cooperative_groups.h>
#include <cstdio>
#include <cstdint>
namespace cg = cooperative_groups;
namespace pg8 {
#define PG8_LAS __attribute__((address_space(3)))
typedef unsigned short bf16_t;
typedef short bf16x8 __attribute__((ext_vector_type(8)));
typedef float f32x4 __attribute__((ext_vector_type(4)));
typedef unsigned u32x4 __attribute__((ext_vector_type(4)));
constexpr int BM = 256, BK = 64, HALF = 128, HTB = HALF * BK * 2  , STAGE_BYTES = 8 * HTB, NXCD = 8, WGM = 8;

__host__ __device__ __forceinline__ int lds_byte(int r, int c) { const int st = (r >> 4) * 2 + (c >> 5), rr = r & 15, cc = c & 31, ob = rr * 64 + cc * 2; return st * 1024 + (ob ^ (((ob >> 9) & 1) << 5)); }
__host__ __device__ __forceinline__ void stage_rc(int b, int& R, int& C) { const int st = b / 1024, sb = b % 1024, swz = sb ^ (((sb >> 9) & 1) << 5); R = (st >> 1) * 16 + swz / 64; C = (st & 1) * 32 + (swz % 64) / 2; }
__host__ __device__ __forceinline__ int perm32(int rho) { const int n = rho >> 4, i = rho & 15; return 8 * (i >> 2) + 4 * n + (i & 3); }

struct Unit { int pm, pn; };
struct Gemm { const bf16_t* A; const bf16_t* Bt; int M, N, K; };

struct StaticOrder {
    int nM, nN, nwg, G, c, rev;
    __host__ __device__ void init(int M, int N, int G_, int c_, int rev_ = 0) { nM = M / BM; nN = N / BM; nwg = nM * nN; G = G_; c = c_; rev = (rev_ && nwg % G_ == 0) ? 1 : 0; }
    __host__ __device__ bool next(int i, Unit& u) const {
        if (rev) { if (i >= nwg / G) return false; i = nwg / G - 1 - i; }
        const long L = (long)i * G + c; if (L >= nwg) return false;
        int wgid = (int)L; { const int q = nwg / NXCD, r = nwg % NXCD, xcd = wgid % NXCD, off = wgid / NXCD; wgid = (xcd < r ? xcd * (q + 1) : r * (q + 1) + (xcd - r) * q) + off; }
        const int nig = WGM * nN, gid = wgid / nig, fm = gid * WGM, gsz = (nM - fm) < WGM ? (nM - fm) : WGM;
        u.pm = fm + ((wgid % nig) % gsz); u.pn = (wgid % nig) / gsz; return true;
    }
    __device__ __forceinline__ void a_ready(const Unit&) const {}
    __device__ __forceinline__ void done(const Unit&) const {}
};

__device__ __forceinline__ unsigned cvt_pk_bf16(float lo, float hi) { unsigned r; asm volatile("v_cvt_pk_bf16_f32 %0, %1, %2" : "=v"(r) : "v"(lo), "v"(hi)); return r; }
template <class Epi, class Sched, bool ALIGN_EPI = false, bool SP2 = false>
__device__ __forceinline__ void gemm_phase(PG8_LAS unsigned char* lds, const Gemm g, const Sched& S, const Epi& E) {
    int tid_ = threadIdx.x; asm volatile("" : "+v"(tid_));
    const int tid = tid_, wid = __builtin_amdgcn_readfirstlane(tid >> 6), lane = tid & 63, wr = wid >> 2, wc = wid & 3, fr = lane & 15, fq = lane >> 4;
    const int K = g.K, nt = K / BK;
    unsigned voffA[2], voffB[2];
#pragma unroll
    for (int i = 0; i < 2; ++i) { int R, C; stage_rc(tid * 16 + i * 8192, R, C); const int Rb = Epi::PERM ? ((R & ~31) + perm32(R & 31)) : R;
        voffA[i] = (unsigned)(R * K + C) * 2u; voffB[i] = (unsigned)(Rb * K + C) * 2u; }
    const size_t kstep = (size_t)(BK * 2);
    const size_t hstep = (size_t)HALF * K * 2;
    const size_t tstep = 2 * hstep;
    const unsigned ldsw = (unsigned)wid * 1024u;
    const int aoff = lds_byte(wr * 64 + fr, fq * 8), boff = lds_byte(wc * 32 + fr, fq * 8);
#define PG8_SA(b, h) (((b) * 2 + (h)) * HTB)
#define PG8_SB(b, h) ((4 + (b) * 2 + (h)) * HTB)
#define PG8_STAGE(bufoff, gbase, voff) do { _Pragma("unroll") for (int _i = 0; _i < 2; ++_i) \
        __builtin_amdgcn_global_load_lds((const unsigned*)((const char*)(gbase) + (voff)[_i]), (PG8_LAS unsigned*)(lds + (bufoff) + ldsw + _i * 8192), 16, 0, 0); } while (0)
#define PG8_LDA(dst, b, h) do { _Pragma("unroll") for (int m = 0; m < 4; ++m) _Pragma("unroll") for (int k = 0; k < 2; ++k) dst[m][k] = *(const PG8_LAS bf16x8*)(lds + PG8_SA(b, h) + aoff + m * 2048 + k * 1024); } while (0)
#define PG8_LDB(dst, b, h) do { _Pragma("unroll") for (int n = 0; n < 2; ++n) _Pragma("unroll") for (int k = 0; k < 2; ++k) dst[n][k] = *(const PG8_LAS bf16x8*)(lds + PG8_SB(b, h) + boff + n * 2048 + k * 1024); } while (0)
#define PG8_MMA(ai, bj, At, Bt) do { __builtin_amdgcn_s_setprio(1); _Pragma("unroll") for (int m = 0; m < 4; ++m) _Pragma("unroll") for (int n = 0; n < 2; ++n) _Pragma("unroll") for (int k = 0; k < 2; ++k) \
        acc[ai][bj][m][n] = __builtin_amdgcn_mfma_f32_16x16x32_bf16(Bt[n][k], At[m][k], acc[ai][bj][m][n], 0, 0, 0); __builtin_amdgcn_s_setprio(0); } while (0)
#define PG8_WAIT_V(n) asm volatile("s_waitcnt vmcnt(" #n ")" ::: "memory")
#define PG8_WAIT_L(n) asm volatile("s_waitcnt lgkmcnt(" #n ")" ::: "memory")
#define PG8_BAR __builtin_amdgcn_s_barrier()
#define PG8_SCHED __builtin_amdgcn_sched_barrier(0)
    Unit cur, nxt; int ui = 0;
    if (!S.next(0, cur)) return;
    f32x4 acc[2][2][4][2];
#pragma unroll
    for (int a = 0; a < 2; ++a)
#pragma unroll
        for (int b = 0; b < 2; ++b)
#pragma unroll
            for (int m = 0; m < 4; ++m)
#pragma unroll
                for (int n = 0; n < 2; ++n) acc[a][b][m][n] = (f32x4){0.f, 0.f, 0.f, 0.f};
    bf16x8 At[4][2], B0[2][2], B1[2][2];
    const char* cA = (const char*)g.A + (size_t)cur.pm * tstep; const char* cB = (const char*)g.Bt + (size_t)cur.pn * tstep;
    S.a_ready(cur);
    if constexpr (SP2) {
        PG8_STAGE(PG8_SB(0, 0), cB, voffB); PG8_STAGE(PG8_SB(0, 1), cB + hstep, voffB); PG8_STAGE(PG8_SA(0, 0), cA, voffA); PG8_STAGE(PG8_SA(0, 1), cA + hstep, voffA);
        if (wr == 1) PG8_BAR;
        PG8_WAIT_V(2); PG8_BAR;
        PG8_STAGE(PG8_SB(1, 0), cB + kstep, voffB); PG8_STAGE(PG8_SA(1, 0), cA + kstep, voffA); PG8_STAGE(PG8_SB(1, 1), cB + hstep + kstep, voffB);
        PG8_WAIT_V(6); PG8_BAR;
    } else {
        PG8_STAGE(PG8_SB(0, 0), cB, voffB); PG8_STAGE(PG8_SA(0, 0), cA, voffA); PG8_STAGE(PG8_SB(0, 1), cB + hstep, voffB); PG8_STAGE(PG8_SA(0, 1), cA + hstep, voffA);
        if (wr == 1) PG8_BAR;
        PG8_WAIT_V(4); PG8_BAR;
        PG8_STAGE(PG8_SB(1, 0), cB + kstep, voffB); PG8_STAGE(PG8_SA(1, 0), cA + kstep, voffA); PG8_STAGE(PG8_SB(1, 1), cB + hstep + kstep, voffB);
        PG8_WAIT_V(6); PG8_BAR;
    }
    for (;;) {
        const bool has_next = S.next(ui + 1, nxt);
        const char* nA = has_next ? (const char*)g.A + (size_t)nxt.pm * tstep : cA; const char* nB = has_next ? (const char*)g.Bt + (size_t)nxt.pn * tstep : cB;
        for (int t = 0; t < nt; t += 2) {
            const bool last = (t == nt - 2);
            const char* a1 = cA + (size_t)(t + 1) * kstep;
            const char* a2 = last ? nA : cA + (size_t)(t + 2) * kstep; const char* b2 = last ? nB : cB + (size_t)(t + 2) * kstep;
            const char* a3 = a2 + kstep; const char* b3 = b2 + kstep;
            if (last && has_next) S.a_ready(nxt);
            if constexpr (SP2) {
            PG8_LDB(B0, 0, 0); PG8_LDB(B1, 0, 1); PG8_SCHED; PG8_LDA(At, 0, 0); PG8_STAGE(PG8_SA(1, 1), a1 + hstep, voffA);
            PG8_WAIT_V(8); PG8_WAIT_L(0); PG8_BAR; PG8_MMA(0, 0, At, B0); PG8_MMA(0, 1, At, B1); PG8_BAR; PG8_SCHED;
            PG8_LDA(At, 0, 1); PG8_STAGE(PG8_SB(0, 0), b2, voffB); PG8_STAGE(PG8_SB(0, 1), b2 + hstep, voffB); PG8_STAGE(PG8_SA(0, 0), a2, voffA);
            PG8_WAIT_V(8); PG8_WAIT_L(0); PG8_BAR; PG8_MMA(1, 0, At, B0); PG8_MMA(1, 1, At, B1); PG8_BAR; PG8_SCHED;
            PG8_LDB(B0, 1, 0); PG8_LDB(B1, 1, 1); PG8_SCHED; PG8_LDA(At, 1, 0); PG8_STAGE(PG8_SA(0, 1), a2 + hstep, voffA);
            PG8_WAIT_V(8); PG8_WAIT_L(0); PG8_BAR; PG8_MMA(0, 0, At, B0); PG8_MMA(0, 1, At, B1); PG8_BAR; PG8_SCHED;
            PG8_LDA(At, 1, 1); PG8_STAGE(PG8_SB(1, 0), b3, voffB); PG8_STAGE(PG8_SB(1, 1), b3 + hstep, voffB); PG8_STAGE(PG8_SA(1, 0), a3, voffA);
            PG8_WAIT_V(8); PG8_WAIT_L(0); PG8_BAR; PG8_MMA(1, 0, At, B0); PG8_MMA(1, 1, At, B1); PG8_BAR; PG8_SCHED;
            } else {
            PG8_LDB(B0, 0, 0); PG8_SCHED; PG8_LDA(At, 0, 0); PG8_STAGE(PG8_SA(1, 1), a1 + hstep, voffA);
            PG8_WAIT_L(8); PG8_BAR; PG8_WAIT_L(0); PG8_MMA(0, 0, At, B0); PG8_BAR; PG8_SCHED;
            PG8_LDB(B1, 0, 1); PG8_STAGE(PG8_SB(0, 0), b2, voffB);
            PG8_BAR; PG8_WAIT_L(0); PG8_MMA(0, 1, At, B1); PG8_BAR;
            PG8_LDA(At, 0, 1); PG8_STAGE(PG8_SA(0, 0), a2, voffA);
            PG8_BAR; PG8_WAIT_L(0); PG8_MMA(1, 0, At, B0); PG8_BAR; PG8_SCHED;
            PG8_STAGE(PG8_SB(0, 1), b2 + hstep, voffB);
            PG8_WAIT_V(6); PG8_BAR; PG8_MMA(1, 1, At, B1); PG8_BAR;
            PG8_LDB(B0, 1, 0); PG8_SCHED; PG8_LDA(At, 1, 0); PG8_STAGE(PG8_SA(0, 1), a2 + hstep, voffA);
            PG8_WAIT_L(8); PG8_BAR; PG8_WAIT_L(0); PG8_MMA(0, 0, At, B0); PG8_BAR; PG8_SCHED;
            PG8_LDB(B1, 1, 1); PG8_STAGE(PG8_SB(1, 0), b3, voffB);
            PG8_BAR; PG8_WAIT_L(0); PG8_MMA(0, 1, At, B1); PG8_BAR;
            PG8_LDA(At, 1, 1); PG8_STAGE(PG8_SA(1, 0), a3, voffA);
            PG8_BAR; PG8_WAIT_L(0); PG8_MMA(1, 0, At, B0); PG8_BAR; PG8_SCHED;
            PG8_STAGE(PG8_SB(1, 1), b3 + hstep, voffB);
            PG8_WAIT_V(6); PG8_BAR; PG8_MMA(1, 1, At, B1); PG8_BAR;
            }
        }
        if constexpr (ALIGN_EPI) { if (wr == 0) PG8_BAR; }
        if constexpr (!Epi::AFTER_DRAIN) { E(acc, cur, wr, wc, fr, fq); S.done(cur); }
        if (!has_next) break;
#pragma unroll
        for (int a = 0; a < 2; ++a)
#pragma unroll
            for (int b = 0; b < 2; ++b)
#pragma unroll
                for (int m = 0; m < 4; ++m)
#pragma unroll
                    for (int n = 0; n < 2; ++n) acc[a][b][m][n] = (f32x4){0.f, 0.f, 0.f, 0.f};
        cur = nxt; cA = nA; cB = nB; ++ui;
        if constexpr (ALIGN_EPI) { if (wr == 1) PG8_BAR; }
    }
    PG8_WAIT_V(0);
    if constexpr (!ALIGN_EPI) { if (wr == 0) PG8_BAR; }
    PG8_BAR;
    if constexpr (Epi::AFTER_DRAIN) { E.fused(acc, cur, wr, wc, fr, fq, lds, wid, lane); S.done(cur); }
#undef PG8_SA
#undef PG8_SB
#undef PG8_STAGE
#undef PG8_LDA
#undef PG8_LDB
#undef PG8_MMA
#undef PG8_WAIT_V
#undef PG8_WAIT_L
#undef PG8_BAR
#undef PG8_SCHED
}
}
#define LAS __attribute__((address_space(3)))
typedef pg8::bf16_t bf16_t;
typedef pg8::bf16x8 bf16x8;
typedef pg8::f32x4 f32x4;
typedef pg8::u32x4 u32x4;
typedef float f32x16 __attribute__((ext_vector_type(16)));
typedef unsigned u32x2 __attribute__((ext_vector_type(2)));
constexpr int SEQ = 8192, NBATCH = 8, DM = 1024, MTOK = NBATCH * SEQ, DEPTH = 4;
constexpr float EPS = 1e-6f, LOG2E = 1.4426950408889634f;
constexpr int TBLN = 2176, TOFF = 32, TS = 2192;
constexpr int WROWS = 10240;
constexpr int WR_GU1 = 0, WR_D1 = 2048, WR_QK = 3072, WR_V = 5120, WR_O = 6144, WR_GU2 = 7168, WR_D2 = 9216;
constexpr size_t MiB = 1u << 20;
constexpr size_t WS_CTL = 0, WS_SS = 1 * MiB, WS_TBL = 8 * MiB, WS_W = 9 * MiB, WS_XB = 96 * MiB, WS_ACT = 224 * MiB, WS_QK = 352 * MiB, WS_VT = 608 * MiB, WS_END = 736 * MiB;
constexpr size_t WS_PRM = WS_TBL + 512 * 1024;
constexpr int PGN = 0  , PSUB = 1024, PRB = 1280, PLAM = 1664, PLAMI = 1668;
typedef unsigned long long u64;
constexpr float SS_SCALE = 1048576.0f, SS_INV = 1.0f / (1048576.0f * 1024.0f);
__device__ __forceinline__ float row_rs(const u64* ss, int row) { return __builtin_amdgcn_rsqf((float)ss[row] * SS_INV + 1e-6f); }
constexpr int LDS_BYTES = 132096;
constexpr int N_B_ITEMS = NBATCH * 4 * 256, N_A_ITEMS = NBATCH * 8 * 256, N_C_ITEMS = NBATCH * 4 * 256, N_ITEMS = N_B_ITEMS + N_A_ITEMS + N_C_ITEMS;

typedef float f32x2_t __attribute__((ext_vector_type(2))); typedef __bf16 bf16x2_t __attribute__((ext_vector_type(2)));
__device__ __forceinline__ unsigned pkbf(float lo, float hi) { const f32x2_t v = {lo, hi}; const bf16x2_t b = __builtin_convertvector(v, bf16x2_t); return __builtin_bit_cast(unsigned, b); }
__device__ __forceinline__ float wave_sum(float v) {
#pragma unroll
    for (int o = 1; o < 64; o <<= 1) v += __shfl_xor(v, o);
    return v;
}
__device__ __forceinline__ float ex2(float x) { return __builtin_amdgcn_exp2f(x); }
__device__ __forceinline__ float lg2(float x) { return __builtin_amdgcn_logf(x); }

struct EpiGU {
    static constexpr bool PERM = true, AFTER_DRAIN = false;
    bf16_t* O; const u64* ss;
    __device__ __forceinline__ void operator()(const f32x4 (&acc)[2][2][4][2], const pg8::Unit& u, int wr, int wc, int fr, int fq) const {
        const int row0 = u.pm * 256 + wr * 64 + fr, col0 = u.pn * 128 + wc * 32 + 8 * fq;
        u64 sv[2][4];
#pragma unroll
        for (int ai = 0; ai < 2; ++ai)
#pragma unroll
            for (int m = 0; m < 4; ++m) sv[ai][m] = ss[row0 + ai * 128 + m * 16];
#pragma unroll
        for (int ai = 0; ai < 2; ++ai)
#pragma unroll
            for (int m = 0; m < 4; ++m) {
                const int row = row0 + ai * 128 + m * 16;
                const float r = __builtin_amdgcn_rsqf((float)sv[ai][m] * SS_INV + 1e-6f);
                float h[8];
#pragma unroll
                for (int n = 0; n < 2; ++n)
#pragma unroll
                    for (int i = 0; i < 4; ++i) { const float g = acc[ai][0][m][n][i] * r, uu = acc[ai][1][m][n][i] * r;
                        h[n * 4 + i] = g * uu * __builtin_amdgcn_rcpf(1.0f + ex2(-g * LOG2E)); }
                u32x4 w; w.x = pkbf(h[0], h[1]); w.y = pkbf(h[2], h[3]); w.z = pkbf(h[4], h[5]); w.w = pkbf(h[6], h[7]);
                *(u32x4*)(O + (size_t)row * DM + col0) = w;
            }
    }
};
template <int MODE  > struct EpiRes {
    static constexpr bool PERM = true, AFTER_DRAIN = false;
    const float* x32; float* out; bf16_t* xb; u64* ssn; float alpha;
    __device__ __forceinline__ void operator()(const f32x4 (&acc)[2][2][4][2], const pg8::Unit& u, int wr, int wc, int fr, int fq) const {
        const int row0 = u.pm * 256 + wr * 64 + fr, col0 = u.pn * 256 + wc * 32 + 8 * fq;
        float sq[2][4];
        if (MODE == 1) {
#pragma unroll
            for (int ai = 0; ai < 2; ++ai) { f32x4 b[4][2][2];
#pragma unroll
                for (int m = 0; m < 4; ++m)
#pragma unroll
                    for (int bj = 0; bj < 2; ++bj) { const size_t off = (size_t)(row0 + ai * 128 + m * 16) * DM + col0 + bj * 128;
                        b[m][bj][0] = *(const f32x4*)(x32 + off); b[m][bj][1] = *(const f32x4*)(x32 + off + 4); }
#pragma unroll
                for (int m = 0; m < 4; ++m) { float q = 0.f;
#pragma unroll
                    for (int bj = 0; bj < 2; ++bj) q += emit(b[m][bj][0] + acc[ai][bj][m][0] * alpha, b[m][bj][1] + acc[ai][bj][m][1] * alpha, (size_t)(row0 + ai * 128 + m * 16) * DM + col0 + bj * 128);
                    sq[ai][m] = q; } }
        } else {
            u32x4 w[2][4][2];
#pragma unroll
            for (int ai = 0; ai < 2; ++ai)
#pragma unroll
                for (int m = 0; m < 4; ++m)
#pragma unroll
                    for (int bj = 0; bj < 2; ++bj) w[ai][m][bj] = *(const u32x4*)(xb + (size_t)(row0 + ai * 128 + m * 16) * DM + col0 + bj * 128);
#pragma unroll
            for (int ai = 0; ai < 2; ++ai)
#pragma unroll
                for (int m = 0; m < 4; ++m) { float q = 0.f;
#pragma unroll
                    for (int bj = 0; bj < 2; ++bj) { const u32x4 t = w[ai][m][bj];
                        const f32x4 b0 = {__uint_as_float(t.x << 16), __uint_as_float(t.x & 0xffff0000u), __uint_as_float(t.y << 16), __uint_as_float(t.y & 0xffff0000u)};
                        const f32x4 b1 = {__uint_as_float(t.z << 16), __uint_as_float(t.z & 0xffff0000u), __uint_as_float(t.w << 16), __uint_as_float(t.w & 0xffff0000u)};
                        q += emit(b0 + acc[ai][bj][m][0] * alpha, b1 + acc[ai][bj][m][1] * alpha, (size_t)(row0 + ai * 128 + m * 16) * DM + col0 + bj * 128); }
                    sq[ai][m] = q; }
        }
        if (MODE != 2) {
#pragma unroll
            for (int ai = 0; ai < 2; ++ai)
#pragma unroll
                for (int m = 0; m < 4; ++m) sq[ai][m] += __shfl_xor(sq[ai][m], 16);
#pragma unroll
            for (int ai = 0; ai < 2; ++ai)
#pragma unroll
                for (int m = 0; m < 4; ++m) sq[ai][m] += __shfl_xor(sq[ai][m], 32);
            if (fq == 0) {
#pragma unroll
                for (int ai = 0; ai < 2; ++ai)
#pragma unroll
                    for (int m = 0; m < 4; ++m) atomicAdd(ssn + row0 + ai * 128 + m * 16, (u64)(sq[ai][m] * SS_SCALE + 0.5f)); }
        }
    }
    __device__ __forceinline__ float emit(const f32x4 v0, const f32x4 v1, size_t off) const {
        if (MODE == 2) { *(f32x4*)(out + off) = v0; *(f32x4*)(out + off + 4) = v1; return 0.f; }
        u32x4 w; w.x = pkbf(v0[0], v0[1]); w.y = pkbf(v0[2], v0[3]); w.z = pkbf(v1[0], v1[1]); w.w = pkbf(v1[2], v1[3]);
        *(u32x4*)(xb + off) = w;
        return (v0[0] * v0[0] + v0[1] * v0[1]) + (v0[2] * v0[2] + v0[3] * v0[3]) + (v1[0] * v1[0] + v1[1] * v1[1]) + (v1[2] * v1[2] + v1[3] * v1[3]);
    }
};
struct EpiQK {
    static constexpr bool PERM = true, AFTER_DRAIN = false;
    bf16_t* O; const u64* ss; const float* gains;
    __device__ __forceinline__ void operator()(const f32x4 (&acc)[2][2][4][2], const pg8::Unit& u, int wr, int wc, int fr, int fq) const {
        const int pn = u.pn, row0 = u.pm * 256 + wr * 64 + fr, col0 = pn * 256 + wc * 64 + 8 * fq;
        const float* g = gains + (pn < 2 ? 0 : (pn < 4 ? 64 : (pn == 4 ? 128 : (pn == 5 ? 160 : 192))));
        const int gstep = pn < 4 ? 32 : 0;
        const float osc = (pn < 2 || pn == 6) ? 0.125f * LOG2E : (pn == 4 ? 0.17677669529663687f * LOG2E : 1.0f);
        const float inv_n = pn < 4 ? (1.0f / 64.0f) : (1.0f / 32.0f);
        const float* gp = g + 8 * fq;
        u64 sv[2][4];
#pragma unroll
        for (int ai = 0; ai < 2; ++ai)
#pragma unroll
            for (int m = 0; m < 4; ++m) sv[ai][m] = ss[row0 + ai * 128 + m * 16];
        f32x4 gg[2][2];
#pragma unroll
        for (int bj = 0; bj < 2; ++bj) { gg[bj][0] = *(const f32x4*)(gp + bj * gstep); gg[bj][1] = *(const f32x4*)(gp + bj * gstep + 4); }
#pragma unroll
        for (int ai = 0; ai < 2; ++ai)
#pragma unroll
            for (int m = 0; m < 4; ++m) {
                const int row = row0 + ai * 128 + m * 16;
                const float r = __builtin_amdgcn_rsqf((float)sv[ai][m] * SS_INV + 1e-6f);
                float s0, s1;
                { const f32x4 a = acc[ai][0][m][0] * r, b = acc[ai][0][m][1] * r; s0 = (a[0] * a[0] + a[1] * a[1]) + (a[2] * a[2] + a[3] * a[3]) + (b[0] * b[0] + b[1] * b[1]) + (b[2] * b[2] + b[3] * b[3]); }
                { const f32x4 a = acc[ai][1][m][0] * r, b = acc[ai][1][m][1] * r; s1 = (a[0] * a[0] + a[1] * a[1]) + (a[2] * a[2] + a[3] * a[3]) + (b[0] * b[0] + b[1] * b[1]) + (b[2] * b[2] + b[3] * b[3]); }
                if (pn < 4) { s0 += s1; s1 = s0; }
                s0 += __shfl_xor(s0, 16); s1 += __shfl_xor(s1, 16); s0 += __shfl_xor(s0, 32); s1 += __shfl_xor(s1, 32);
                float rn0 = osc * r, rn1 = osc * r;
                if (pn < 6) { rn0 *= __builtin_amdgcn_rsqf(s0 * inv_n + EPS); rn1 *= __builtin_amdgcn_rsqf(s1 * inv_n + EPS); }
#pragma unroll
                for (int bj = 0; bj < 2; ++bj) { const float rn = bj ? rn1 : rn0;
                    const f32x4 y0 = acc[ai][bj][m][0] * gg[bj][0] * rn, y1 = acc[ai][bj][m][1] * gg[bj][1] * rn;
                    u32x4 w; w.x = pkbf(y0[0], y0[1]); w.y = pkbf(y0[2], y0[3]); w.z = pkbf(y1[0], y1[1]); w.w = pkbf(y1[2], y1[3]);
                    *(u32x4*)(O + (size_t)row * 2048 + col0 + 32 * bj) = w; }
            }
    }
};
struct EpiVT {
    static constexpr bool PERM = true, AFTER_DRAIN = false;
    bf16_t* O; const u64* ss;
    __device__ __forceinline__ void operator()(const f32x4 (&acc)[2][2][4][2], const pg8::Unit& u, int wr, int wc, int fr, int fq) const {
        const int row0 = u.pm * 256 + wr * 64 + fr, col0 = u.pn * 256 + wc * 32 + 8 * fq;
        f32x4 r[2][2];
#pragma unroll
        for (int bj = 0; bj < 2; ++bj)
#pragma unroll
            for (int n = 0; n < 2; ++n) {
#pragma unroll
                for (int i = 0; i < 4; ++i) r[bj][n][i] = row_rs(ss, col0 + bj * 128 + 4 * n + i); }
#pragma unroll
        for (int ai = 0; ai < 2; ++ai)
#pragma unroll
            for (int m = 0; m < 4; ++m) {
                const int row = row0 + ai * 128 + m * 16;
#pragma unroll
                for (int bj = 0; bj < 2; ++bj) { const f32x4 y0 = acc[ai][bj][m][0] * r[bj][0], y1 = acc[ai][bj][m][1] * r[bj][1];
                    u32x4 w; w.x = pkbf(y0[0], y0[1]); w.y = pkbf(y0[2], y0[3]); w.z = pkbf(y1[0], y1[1]); w.w = pkbf(y1[2], y1[3]);
                    *(u32x4*)(O + (size_t)row * MTOK + col0 + bj * 128) = w; }
            }
    }
};

struct Args {
    const float *x, *rel_bias, *ffn1_norm, *ffn1_wg, *ffn1_wu, *ffn1_wd, *mix_norm, *w_in, *qna, *kna, *qnb, *knb, *lq1, *lk1, *lq2, *lk2, *subln, *w_out, *ffn2_norm, *ffn2_wg, *ffn2_wu, *ffn2_wd;
    float* out; unsigned char* ws; int ph_lo, ph_hi;
};

struct TrItem { const float* src; const float* gain; bf16_t* dst; int Nsrc, c0, k0; };
__device__ __forceinline__ void tr_load(const TrItem& d, float (&tv)[32], int lane) {
#pragma unroll
    for (int i = 0; i < 32; ++i) tv[i] = d.src[(size_t)(d.k0 + 2 * i + (lane >> 5)) * d.Nsrc + d.c0 + (lane & 31)];
}
__device__ __forceinline__ void tr_store(const TrItem& d, float (&tv)[32], LAS float* scr, int lane) {
    if (d.gain) {
#pragma unroll
        for (int i = 0; i < 32; ++i) tv[i] *= d.gain[d.k0 + 2 * i + (lane >> 5)]; }
#pragma unroll
    for (int i = 0; i < 32; ++i) scr[(2 * i + (lane >> 5)) * 33 + (lane & 31)] = tv[i];
    asm volatile("s_waitcnt lgkmcnt(0)" ::: "memory");
    const int c = lane & 7;
#pragma unroll
    for (int j = 0; j < 4; ++j) { const int n = (lane >> 3) + 8 * j; const LAS float* s = scr + (8 * c) * 33 + n;
        u32x4 o; o.x = pkbf(s[0 * 33], s[1 * 33]); o.y = pkbf(s[2 * 33], s[3 * 33]); o.z = pkbf(s[4 * 33], s[5 * 33]); o.w = pkbf(s[6 * 33], s[7 * 33]);
        *(u32x4*)(d.dst + (size_t)n * 1024 + d.k0 + 8 * c) = o; }
    asm volatile("s_waitcnt lgkmcnt(0)" ::: "memory");
}
__device__ __forceinline__ int t5_bucket(int dist) {
    if (dist < 16) return dist;
    const int large = 16 + (int)(logf((float)dist / 16.0f) / 4.852030263919617f * 16.0f);
    return large < 31 ? large : 31;
}
__device__ __forceinline__ void prologue(const Args& a, LAS unsigned char* lds, int tid, int wave, int lane) {
    const int gw = blockIdx.x * 8 + wave, NGW = gridDim.x * 8;
    unsigned char* ws = a.ws;
    bf16_t* Wb = (bf16_t*)(ws + WS_W);
    LAS float* scr = (LAS float*)(lds + wave * 16384);
#define TR_DECODE(d_, it_) do { const int l = (it_) / 5120, r = (it_) % 5120, rb = r >> 4; (d_).k0 = (r & 15) * 64; (d_).Nsrc = 1024; (d_).gain = nullptr; \
        if (rb < 64 || (rb >= 224 && rb < 288)) { const bool second = rb >= 224; const int n = (second ? rb - 224 : rb) * 32, pn = n >> 8, bj = (n >> 7) & 1, j = n & 127; \
            (d_).src = (second ? (bj ? a.ffn2_wu : a.ffn2_wg) : (bj ? a.ffn1_wu : a.ffn1_wg)) + (size_t)l * 1048576; (d_).c0 = 128 * pn + j; (d_).gain = (second ? a.ffn2_norm : a.ffn1_norm) + l * 1024; } \
        else if (rb < 96) { (d_).src = a.ffn1_wd + (size_t)l * 1048576; (d_).c0 = (rb - 64) * 32; } \
        else if (rb < 160) { const int n = (rb - 96) * 32, pn = n >> 8, bj = (n >> 7) & 1, wc = (n >> 5) & 3, f = 256 * pn + 64 * wc + 32 * bj; \
            (d_).c0 = f < 1024 ? f : (f < 1536 ? 1536 + (f - 1024) : 2304 + (f - 1536)); (d_).src = a.w_in + (size_t)l * 3145728; (d_).Nsrc = 3072; (d_).gain = a.mix_norm + l * 1024; } \
        else if (rb < 192) { const int g = (rb - 160) * 32; (d_).c0 = g < 512 ? 1024 + g : (g < 768 ? 2048 + (g - 512) : 2816 + (g - 768)); (d_).src = a.w_in + (size_t)l * 3145728; (d_).Nsrc = 3072; (d_).gain = a.mix_norm + l * 1024; } \
        else if (rb < 224) { (d_).src = a.w_out + (size_t)l * 1048576; (d_).c0 = (rb - 192) * 32; } \
        else { (d_).src = a.ffn2_wd + (size_t)l * 1048576; (d_).c0 = (rb - 288) * 32; } \
        (d_).dst = Wb + ((size_t)l * WROWS + rb * 32) * 1024; } while (0)
    if (gw < DEPTH * 5120) {
        TrItem cur; float tv[32]; int it = gw; TR_DECODE(cur, it); tr_load(cur, tv, lane);
        for (;;) {
            const int nx = it + NGW; const bool has = nx < DEPTH * 5120; TrItem nxt = cur; float tn[32];
            if (has) { TR_DECODE(nxt, nx); tr_load(nxt, tn, lane); }
            tr_store(cur, tv, scr, lane);
            if (!has) break;
            cur = nxt; it = nx;
#pragma unroll
            for (int i = 0; i < 32; ++i) tv[i] = tn[i];
        }
    }
    bf16_t* xb = (bf16_t*)(ws + WS_XB); u64* ss = (u64*)(ws + WS_SS);
    if (gw * 4 < MTOK) {
        f32x4 v[4][4]; int rb4 = gw * 4;
#pragma unroll
        for (int r = 0; r < 4; ++r) { const f32x4* xr = (const f32x4*)(a.x + (size_t)(rb4 + r) * DM) + lane;
#pragma unroll
            for (int j = 0; j < 4; ++j) v[r][j] = xr[64 * j]; }
        for (;;) {
            const int nx = rb4 + NGW * 4; const bool has = nx < MTOK; f32x4 vn[4][4];
            if (has) {
#pragma unroll
                for (int r = 0; r < 4; ++r) { const f32x4* xr = (const f32x4*)(a.x + (size_t)(nx + r) * DM) + lane;
#pragma unroll
                    for (int j = 0; j < 4; ++j) vn[r][j] = xr[64 * j]; } }
            float sm[4];
#pragma unroll
            for (int r = 0; r < 4; ++r) { float s = 0.f;
#pragma unroll
                for (int j = 0; j < 4; ++j) s += (v[r][j][0] * v[r][j][0] + v[r][j][1] * v[r][j][1]) + (v[r][j][2] * v[r][j][2] + v[r][j][3] * v[r][j][3]);
                sm[r] = s; }
#pragma unroll
            for (int o = 1; o < 64; o <<= 1) {
#pragma unroll
                for (int r = 0; r < 4; ++r) sm[r] += __shfl_xor(sm[r], o); }
#pragma unroll
            for (int r = 0; r < 4; ++r) { u32x2* o8 = (u32x2*)(xb + (size_t)(rb4 + r) * DM) + lane;
#pragma unroll
                for (int j = 0; j < 4; ++j) { u32x2 w; w.x = pkbf(v[r][j][0], v[r][j][1]); w.y = pkbf(v[r][j][2], v[r][j][3]); o8[64 * j] = w; }
                if (lane == 0) ss[rb4 + r] = (u64)(sm[r] * SS_SCALE + 0.5f); }
            if (!has) break;
            rb4 = nx;
#pragma unroll
            for (int r = 0; r < 4; ++r)
#pragma unroll
                for (int j = 0; j < 4; ++j) v[r][j] = vn[r][j];
        }
    }
    const int gt = blockIdx.x * 512 + tid, NGT = gridDim.x * 512;
    for (int i = gt; i < 12 * MTOK; i += NGT) ss[MTOK + i] = 0ull;
    if (gt < 64) ((unsigned*)(ws + WS_CTL))[gt] = 0u;
    float* prm = (float*)(ws + WS_PRM);
    if (gt < 1024) { const int l = gt >> 8, j = gt & 255;
        prm[PGN + gt] = j < 64 ? a.qna[l * 64 + j] : (j < 128 ? a.kna[l * 64 + j - 64] : (j < 160 ? a.qnb[l * 32 + j - 128] : (j < 192 ? a.knb[l * 32 + j - 160] : 1.0f))); }
    if (gt < 256) prm[PSUB + gt] = a.subln[gt];
    if (gt < 384) prm[PRB + gt] = a.rel_bias[gt];
    if (gt < DEPTH) { float d1 = 0.f, d2 = 0.f;
        for (int i = 0; i < 32; ++i) { d1 += a.lq1[gt * 32 + i] * a.lk1[gt * 32 + i]; d2 += a.lq2[gt * 32 + i] * a.lk2[gt * 32 + i]; }
        const float lam_init = 0.8f - 0.6f * expf(-0.3f * (float)gt);
        prm[PLAM + gt] = expf(d1) - expf(d2) + lam_init; prm[PLAMI + gt] = lam_init; }
    float* tb = (float*)(ws + WS_TBL);
    for (int i = gt; i < 12 * 4 * TS; i += NGT) {
        const int h = i / (4 * TS), xx = (i % TS) + ((i / TS) & 3), dist = (TBLN - 1 - xx) - TOFF;
        float val = -1e30f;
        if (xx < TBLN && dist >= 0) {
            const float bias = a.rel_bias[t5_bucket(dist) * 12 + h] * LOG2E;
            if (h >= 8) val = bias;
            else { const int mult = (dist <= 128 ? 1 : 0) + (((dist & 3) == 0 && dist <= 512) ? 1 : 0) + (((dist & 15) == 0 && dist <= 2048) ? 1 : 0);
                if (mult > 0) val = bias + (mult == 1 ? 0.f : (mult == 2 ? 1.0f : 1.5849625007211562f)); }
        }
        tb[i] = val;
    }
}

__device__ __forceinline__ f32x16 mfma32(bf16x8 a, bf16x8 b, f32x16 c) { return __builtin_amdgcn_mfma_f32_32x32x16_bf16(a, b, c, 0, 0, 0); }
#define CIDX(i) (16 * ((i) >> 3) + ((i) & 7))
__device__ __forceinline__ void pack_p(const f32x16& p, bf16x8& lo, bf16x8& hi) {
    u32x4 a, b; a.x = pkbf(p[0], p[1]); a.y = pkbf(p[2], p[3]); a.z = pkbf(p[4], p[5]); a.w = pkbf(p[6], p[7]);
    b.x = pkbf(p[8], p[9]); b.y = pkbf(p[10], p[11]); b.z = pkbf(p[12], p[13]); b.w = pkbf(p[14], p[15]);
    lo = __builtin_bit_cast(bf16x8, a); hi = __builtin_bit_cast(bf16x8, b);
}
__device__ __forceinline__ void store_ot(bf16_t* dst, const f32x16& o, float sc, int h) {
#pragma unroll
    for (int c = 0; c < 4; ++c) { u32x2 w; w.x = pkbf(o[4 * c] * sc, o[4 * c + 1] * sc); w.y = pkbf(o[4 * c + 2] * sc, o[4 * c + 3] * sc); *(u32x2*)(dst + 8 * c + 4 * h) = w; }
}

constexpr int SBUF_OFF = 4 * TS * 4  , STG_BYTES = 16384, NSTG = 3, ITEM_OFF = 131072  ;
static_assert(ITEM_OFF + 1024 <= LDS_BYTES && SBUF_OFF % 16 == 0 && SBUF_OFF + NSTG * STG_BYTES <= ITEM_OFF, "LDS map");
struct Stage { const bf16_t* ksrc; const bf16_t* vsrc; unsigned kdst, vdst; };
__device__ __forceinline__ Stage make_stage(int tid, const bf16_t* QK, const bf16_t* VT, size_t tok0, int kcol, int vrow) {
    Stage st; const int w = __builtin_amdgcn_readfirstlane(tid >> 6), l = tid & 63, h = l >> 5, r5 = l & 31, pr = (r5 & ~12) | ((r5 & 4) << 1) | ((r5 & 8) >> 1), u = w >> 2;
    st.ksrc = QK + (tok0 + 32 * u + pr) * 2048 + kcol + 16 * (w & 3) + 8 * h; st.kdst = (unsigned)(u * 8192 + (w & 3) * 1024);
    st.vsrc = VT + (size_t)(vrow + 32 * ((w >> 1) & 1) + r5) * MTOK + tok0 + 32 * u + 16 * (w & 1) + 8 * h; st.vdst = (unsigned)(u * 8192 + 4096 + (w & 3) * 1024);
    return st;
}
#define STG_ISSUE(idx_, slot_) do { LAS unsigned char* d_ = sb + (slot_) * STG_BYTES; \
    __builtin_amdgcn_global_load_lds((const unsigned*)(st.ksrc + (size_t)(idx_) * (64 * 2048)), (LAS unsigned*)(d_ + st.kdst), 16, 0, 0); \
    __builtin_amdgcn_global_load_lds((const unsigned*)(st.vsrc + (idx_) * 64), (LAS unsigned*)(d_ + st.vdst), 16, 0, 0); } while (0)
#define WAITBAR2() asm volatile("s_waitcnt vmcnt(2) lgkmcnt(0)\n\ts_barrier" ::: "memory")
#define DRAIN_DMA() asm volatile("s_waitcnt vmcnt(0)" ::: "memory")
#define FRAG_LOAD(cb_) do { LOADK(kf, cb_); LOADV(vf, cb_); } while (0)
#define LOADK(kf_, cb_) do { _Pragma("unroll") for (int s_ = 0; s_ < 4; ++s_) kf_[s_] = *(const LAS bf16x8*)((cb_) + s_ * 1024); } while (0)
#define LOADV(vf_, cb_) do { _Pragma("unroll") for (int d_ = 0; d_ < 2; ++d_) _Pragma("unroll") for (int s_ = 0; s_ < 2; ++s_) vf_[d_][s_] = *(const LAS bf16x8*)((cb_) + 4096 + (d_ * 2 + s_) * 1024); } while (0)
#define LOADT(t_, tp_) do { const f32x4 a_ = *(const LAS f32x4*)(tp_), b_ = *(const LAS f32x4*)((tp_) + 16), c_ = *(const LAS f32x4*)((tp_) + 64), d_ = *(const LAS f32x4*)((tp_) + 80); \
    t_ = (f32x16){a_[0], a_[1], a_[2], a_[3], b_[0], b_[1], b_[2], b_[3], c_[0], c_[1], c_[2], c_[3], d_[0], d_[1], d_[2], d_[3]}; } while (0)
#define LOAD_HEAD_TABLE(hidx_) do { const u32x4* g4_ = (const u32x4*)(tblg + (size_t)(hidx_) * 4 * TS); LAS u32x4* t4_ = (LAS u32x4*)lds; u32x4 v_[5]; \
    _Pragma("unroll") for (int j_ = 0; j_ < 5; ++j_) { const int i_ = j_ * 512 + tid; if (i_ < TS) v_[j_] = g4_[i_]; } \
    _Pragma("unroll") for (int j_ = 0; j_ < 5; ++j_) { const int i_ = j_ * 512 + tid; if (i_ < TS) t4_[i_] = v_[j_]; } } while (0)
#define LANE_TBL() ((const LAS unsigned char*)lds + (((TBLN - 1 - TOFF) - q + 8 * h) & 3) * (TS * 4) + ((((TBLN - 1 - TOFF) - q + 8 * h) & ~3)) * 4)
#define SCHED_FENCE() __builtin_amdgcn_sched_barrier(0)

__device__ __forceinline__ void sm_A(f32x16& sc, float& l, bf16x8& p0, bf16x8& p1) {
#pragma unroll
    for (int i = 0; i < 16; ++i) { const float p = ex2(sc[i]); sc[i] = p; l += p; }
    pack_p(sc, p0, p1);
}
__device__ __forceinline__ void pv4(const bf16x8 (&vf)[2][2], bf16x8 p0, bf16x8 p1, f32x16& o0, f32x16& o1) {
    o0 = mfma32(vf[0][0], p0, o0); o1 = mfma32(vf[1][0], p0, o1); o0 = mfma32(vf[0][1], p1, o0); o1 = mfma32(vf[1][1], p1, o1);
}
__device__ __forceinline__ void sub_A(const bf16x8 (&kf)[4], const bf16x8 (&vf)[2][2], const bf16x8 (&qf)[4], f32x16 sc  , f32x16& o0, f32x16& o1, float& l) {
#pragma unroll
    for (int s = 0; s < 4; ++s) sc = mfma32(kf[s], qf[s], sc);
    bf16x8 p0, p1; sm_A(sc, l, p0, p1);
    pv4(vf, p0, p1, o0, o1);
}
__device__ __forceinline__ void blk_A(int b, int hd, int chunk  , const bf16_t* QK, const bf16_t* VT, bf16_t* mixed, LAS unsigned char* lds, const float* tblg, int tid, int lane, int wave) {
    const int q = lane & 31, h = lane >> 5, qbA = chunk * 16 + wave, qbB = qbA + 8;
    LOAD_HEAD_TABLE(hd);
    const size_t tok0 = (size_t)b * SEQ;
    bf16x8 qfA[4], qfB[4];
    { const bf16_t* Qp = QK + (tok0 + qbA * 32 + q) * 2048 + hd * 64 + 8 * h;
#pragma unroll
      for (int s = 0; s < 4; ++s) { qfA[s] = *(const bf16x8*)(Qp + 16 * s); qfB[s] = *(const bf16x8*)(Qp + (size_t)8 * 32 * 2048 + 16 * s); } }
    const Stage st = make_stage(tid, QK, VT, tok0, 512 + hd * 64, hd * 64);
    LAS unsigned char* sb = lds + SBUF_OFF;
    const int sb_end = chunk * 8 + 7, sb_lo = chunk * 8 > 32 ? chunk * 8 - 32 : 0;
    int s_iss = sb_lo, slot_i = 0, slot_c = 0;
#define ISSUE_UP() do { STG_ISSUE(s_iss < sb_end ? s_iss : sb_end, slot_i); ++s_iss; slot_i = slot_i == NSTG - 1 ? 0 : slot_i + 1; } while (0)
    ISSUE_UP(); ISSUE_UP();
    WAITBAR2();
    f32x16 oA0 = {}, oA1 = {}, oB0 = {}, oB1 = {}; float lA = 0.f, lB = 0.f;
    const LAS unsigned char* tb = LANE_TBL();
    for (int sbk = sb_lo; sbk <= sb_end; ++sbk) {
        ISSUE_UP();
        const LAS unsigned char* cb = sb + slot_c * STG_BYTES + lane * 16;
#pragma unroll
        for (int u = 0; u < 2; ++u) {
            const int kb = 2 * sbk + u; const bool cA = kb <= qbA && kb + 64 >= qbA, cB = kb <= qbB && kb + 64 >= qbB;
            if (cA || cB) {
                bf16x8 kf[4], vf[2][2];
                LOADK(kf, cb + u * 8192); LOADV(vf, cb + u * 8192);
                if (cA) { f32x16 tA; LOADT(tA, tb - (qbA - kb) * 128); SCHED_FENCE(); sub_A(kf, vf, qfA, tA, oA0, oA1, lA); }
                if (cB) { f32x16 tB; LOADT(tB, tb - (qbB - kb) * 128); SCHED_FENCE(); sub_A(kf, vf, qfB, tB, oB0, oB1, lB); }
            }
        }
        WAITBAR2();
        slot_c = slot_c == NSTG - 1 ? 0 : slot_c + 1;
    }
    DRAIN_DMA();
    lA += __shfl_xor(lA, 32); lB += __shfl_xor(lB, 32);
    const float invA = 1.0f / lA, invB = 1.0f / lB;
    bf16_t* op = mixed + (tok0 + qbA * 32 + q) * DM + hd * 64;
    store_ot(op, oA0, invA, h); store_ot(op + 32, oA1, invA, h);
    op += (size_t)8 * 32 * DM;
    store_ot(op, oB0, invB, h); store_ot(op + 32, oB1, invB, h);
}

__device__ __forceinline__ void sub_B(const bf16x8 (&kf)[4], const bf16x8 (&vf)[2][2], const bf16x8 (&qf)[4], const f32x16& t  , f32x16& oa0, f32x16& oa1, f32x16& ob0, f32x16& ob1, float& la, float& lb) {
    f32x16 sa = mfma32(kf[0], qf[0], t); f32x16 sb2 = mfma32(kf[2], qf[2], t); sa = mfma32(kf[1], qf[1], sa); sb2 = mfma32(kf[3], qf[3], sb2);
    SCHED_FENCE();
    bf16x8 pa0, pa1, pb0, pb1;
    sm_A(sa, la, pa0, pa1);
    SCHED_FENCE();
    pv4(vf, pa0, pa1, oa0, oa1);
    SCHED_FENCE();
    sm_A(sb2, lb, pb0, pb1);
    SCHED_FENCE();
    pv4(vf, pb0, pb1, ob0, ob1);
}
#define EXP4(S_, b_) do { S_[b_] = ex2(S_[b_]); S_[(b_) + 1] = ex2(S_[(b_) + 1]); S_[(b_) + 2] = ex2(S_[(b_) + 2]); S_[(b_) + 3] = ex2(S_[(b_) + 3]); } while (0)
#define SUM16(S_, l_) do { l_ += ((S_[0] + S_[1]) + (S_[2] + S_[3])) + ((S_[4] + S_[5]) + (S_[6] + S_[7])) + ((S_[8] + S_[9]) + (S_[10] + S_[11])) + ((S_[12] + S_[13]) + (S_[14] + S_[15])); } while (0)
__device__ __forceinline__ void step_B(const bool FAR, const LAS unsigned char* cb, const LAS unsigned char* tp0, const LAS unsigned char* tp1, const bf16x8 (&qf)[4],
                                       f32x16& oa0, f32x16& oa1, f32x16& ob0, f32x16& ob1, float& la, float& lb) {
    bf16x8 kfA[4], vfA[2][2], kfB[4], vfB[2][2]; f32x16 tA, tB;
    LOADK(kfA, cb); if (!FAR) LOADT(tA, tp0); LOADV(vfA, cb);
    SCHED_FENCE();
    f32x16 S0, S1;
    if (FAR) { S0 = mfma32(kfA[0], qf[0], f32x16{}); S1 = mfma32(kfA[2], qf[2], f32x16{}); }
    else { S0 = mfma32(kfA[0], qf[0], tA); S1 = mfma32(kfA[2], qf[2], tA); }
    S0 = mfma32(kfA[1], qf[1], S0); S1 = mfma32(kfA[3], qf[3], S1);
    kfB[0] = *(const LAS bf16x8*)(cb + 8192); kfB[1] = *(const LAS bf16x8*)(cb + 8192 + 1024); if (!FAR) LOADT(tB, tp1);
    SCHED_FENCE();
    bf16x8 p0, p1, r0, r1;
    f32x16 S2; if (FAR) S2 = mfma32(kfB[0], qf[0], f32x16{}); else S2 = mfma32(kfB[0], qf[0], tB);
    EXP4(S0, 0); EXP4(S0, 4); SCHED_FENCE();
    S2 = mfma32(kfB[1], qf[1], S2); EXP4(S0, 8); EXP4(S0, 12); SCHED_FENCE();
    SUM16(S0, la); pack_p(S0, p0, p1); SCHED_FENCE();
    f32x16 tB2; kfB[2] = *(const LAS bf16x8*)(cb + 8192 + 2048); kfB[3] = *(const LAS bf16x8*)(cb + 8192 + 3072); if (!FAR) LOADT(tB2, tp1);
    oa0 = mfma32(vfA[0][0], p0, oa0); EXP4(S1, 0); SCHED_FENCE();
    oa1 = mfma32(vfA[1][0], p0, oa1); EXP4(S1, 4); SCHED_FENCE();
    oa0 = mfma32(vfA[0][1], p1, oa0); EXP4(S1, 8); SCHED_FENCE();
    oa1 = mfma32(vfA[1][1], p1, oa1); EXP4(S1, 12); SCHED_FENCE();
    f32x16 S3; if (FAR) S3 = mfma32(kfB[2], qf[2], f32x16{}); else S3 = mfma32(kfB[2], qf[2], tB2);
    SUM16(S1, lb); SCHED_FENCE();
    S3 = mfma32(kfB[3], qf[3], S3); pack_p(S1, r0, r1); SCHED_FENCE();
    LOADV(vfB, cb + 8192);
    ob0 = mfma32(vfA[0][0], r0, ob0); EXP4(S2, 0); SCHED_FENCE();
    ob1 = mfma32(vfA[1][0], r0, ob1); EXP4(S2, 4); SCHED_FENCE();
    ob0 = mfma32(vfA[0][1], r1, ob0); EXP4(S2, 8); SCHED_FENCE();
    ob1 = mfma32(vfA[1][1], r1, ob1); EXP4(S2, 12); SCHED_FENCE();
    SUM16(S2, la); pack_p(S2, p0, p1); SCHED_FENCE();
    oa0 = mfma32(vfB[0][0], p0, oa0); EXP4(S3, 0); SCHED_FENCE();
    oa1 = mfma32(vfB[1][0], p0, oa1); EXP4(S3, 4); SCHED_FENCE();
    oa0 = mfma32(vfB[0][1], p1, oa0); EXP4(S3, 8); SCHED_FENCE();
    oa1 = mfma32(vfB[1][1], p1, oa1); EXP4(S3, 12); SCHED_FENCE();
    SUM16(S3, lb); pack_p(S3, r0, r1); SCHED_FENCE();
    ob0 = mfma32(vfB[0][0], r0, ob0); ob1 = mfma32(vfB[1][0], r0, ob1); ob0 = mfma32(vfB[0][1], r1, ob0); ob1 = mfma32(vfB[1][1], r1, ob1);
}
__device__ __forceinline__ void blk_B(int b, int hd, int chunk, const bf16_t* QK, const bf16_t* VT, bf16_t* mixed, LAS unsigned char* lds, const float* tblg, float wfar, float lam, float osc, const float* subln, int tid, int lane, int wave) {
    const int q = lane & 31, h = lane >> 5, qb = chunk * 8 + wave;
    LOAD_HEAD_TABLE(8 + hd);
    const size_t tok0 = (size_t)b * SEQ;
    const bf16_t* Qp = QK + (tok0 + qb * 32 + q) * 2048 + 1024 + hd * 64 + 8 * h;
    bf16x8 qf[4];
#pragma unroll
    for (int s = 0; s < 4; ++s) qf[s] = *(const bf16x8*)(Qp + 16 * s);
    const Stage st = make_stage(tid, QK, VT, tok0, 1280 + hd * 64, 512 + hd * 64);
    LAS unsigned char* sb = lds + SBUF_OFF;
    const int sb_end = chunk * 4 + 3;
    int s_iss = 0, slot_i = 0, slot_c = 0;
    ISSUE_UP(); ISSUE_UP();
    WAITBAR2();
    f32x16 oa0 = {}, oa1 = {}, ob0 = {}, ob1 = {}; float la = 0.f, lb = 0.f; bool scaled = false;
    const LAS unsigned char* tb = LANE_TBL();
    for (int sbk = 0; sbk <= sb_end; ++sbk) {
        ISSUE_UP();
        const LAS unsigned char* cb = sb + slot_c * STG_BYTES + lane * 16;
        const int kb0 = 2 * sbk, kb1 = kb0 + 1; const bool c0 = kb0 <= qb, c1 = kb1 <= qb;
        if (c0 && c1) {
            const bool far = qb - kb1 >= 49;
            if (!far && !scaled) { scaled = true;
#pragma unroll
                for (int i = 0; i < 16; ++i) { oa0[i] *= wfar; oa1[i] *= wfar; ob0[i] *= wfar; ob1[i] *= wfar; }
                la *= wfar; lb *= wfar; }
            const int d0 = qb - kb0 < 64 ? qb - kb0 : 64, d1 = qb - kb1 < 64 ? qb - kb1 : 64;
            step_B(far, cb, tb - d0 * 128, tb - d1 * 128, qf, oa0, oa1, ob0, ob1, la, lb);
        } else if (c0) {
            bf16x8 kfA[4], vfA[2][2]; f32x16 tA;
            const int d0 = qb - kb0 < 64 ? qb - kb0 : 64;
            LOADK(kfA, cb); LOADT(tA, tb - d0 * 128); LOADV(vfA, cb);
            SCHED_FENCE();
            sub_B(kfA, vfA, qf, tA, oa0, oa1, ob0, ob1, la, lb);
        }
        WAITBAR2();
        slot_c = slot_c == NSTG - 1 ? 0 : slot_c + 1;
    }
    DRAIN_DMA();
    la += __shfl_xor(la, 32); lb += __shfl_xor(lb, 32);
    const float ia = 1.0f / la, ib = lam / lb;
    float sq = 0.f;
#pragma unroll
    for (int i = 0; i < 16; ++i) { oa0[i] = oa0[i] * ia - ob0[i] * ib; oa1[i] = oa1[i] * ia - ob1[i] * ib; sq += oa0[i] * oa0[i] + oa1[i] * oa1[i]; }
    sq += __shfl_xor(sq, 32);
    const float rn = __builtin_amdgcn_rsqf(sq * (1.0f / 64.0f) + EPS) * osc;
    bf16_t* op = mixed + (tok0 + qb * 32 + q) * DM + 512 + hd * 64;
#pragma unroll
    for (int c = 0; c < 4; ++c) { const f32x4 g0 = *(const f32x4*)(subln + 8 * c + 4 * h), g1 = *(const f32x4*)(subln + 32 + 8 * c + 4 * h);
        u32x2 w; w.x = pkbf(oa0[4 * c] * rn * g0[0], oa0[4 * c + 1] * rn * g0[1]); w.y = pkbf(oa0[4 * c + 2] * rn * g0[2], oa0[4 * c + 3] * rn * g0[3]); *(u32x2*)(op + 8 * c + 4 * h) = w;
        w.x = pkbf(oa1[4 * c] * rn * g1[0], oa1[4 * c + 1] * rn * g1[1]); w.y = pkbf(oa1[4 * c + 2] * rn * g1[2], oa1[4 * c + 3] * rn * g1[3]); *(u32x2*)(op + 32 + 8 * c + 4 * h) = w; }
}

__device__ __forceinline__ void sub_C(const LAS unsigned char* cb, const bf16x8 (&qf)[4], int kq, int h, f32x16& o0, f32x16& o1, float& carry) {
    bf16x8 kf[4], vf[2][2]; FRAG_LOAD(cb);
    f32x16 z = {};
#pragma unroll
    for (int s = 0; s < 4; ++s) z = mfma32(kf[s], qf[s], z);
    f32x16 L;
#pragma unroll
    for (int i = 0; i < 16; ++i) { const float az = __builtin_fabsf(z[i]); const float sp = __builtin_fmaxf(z[i], 0.f) + lg2(1.0f + ex2(-az)); L[i] = (CIDX(i) < kq) ? -sp : 0.f; }
#pragma unroll
    for (int i = 6; i >= 0; --i) { L[i] += L[i + 1]; L[8 + i] += L[8 + i + 1]; }
    const float Tlo = L[0], Thi = L[8], Tlo_o = __shfl_xor(Tlo, 32), Thi_o = __shfl_xor(Thi, 32);
    const float off_hi = carry + (h ? 0.f : Thi_o);
    const float off_lo = carry + Thi + Thi_o + (h ? 0.f : Tlo_o);
    carry += (Tlo + Thi) + (Tlo_o + Thi_o);
#pragma unroll
    for (int i = 0; i < 16; ++i) { const float la = z[i] + L[i] + (i < 8 ? off_lo : off_hi); z[i] = (CIDX(i) < kq) ? ex2(la) : 0.f; }
    bf16x8 p0, p1; pack_p(z, p0, p1);
    o0 = mfma32(vf[0][0], p0, o0); o0 = mfma32(vf[0][1], p1, o0);
    o1 = mfma32(vf[1][0], p0, o1); o1 = mfma32(vf[1][1], p1, o1);
}
__device__ __forceinline__ void blk_C(int b, int hd, int chunk, const bf16_t* QK, const bf16_t* VT, bf16_t* mixed, LAS unsigned char* lds, int tid, int lane, int wave) {
    const int q = lane & 31, h = lane >> 5, qb = chunk * 8 + wave;
    const size_t tok0 = (size_t)b * SEQ;
    const bf16_t* Qp = QK + (tok0 + qb * 32 + q) * 2048 + 1536 + hd * 64 + 8 * h;
    bf16x8 qf[4];
#pragma unroll
    for (int s = 0; s < 4; ++s) qf[s] = *(const bf16x8*)(Qp + 16 * s);
    const Stage st = make_stage(tid, QK, VT, tok0, 1792 + hd * 64, 768 + hd * 64);
    LAS unsigned char* sb = lds + SBUF_OFF; volatile LAS unsigned* flags = (volatile LAS unsigned*)(lds + ITEM_OFF) + 16;
    const int sb_end = chunk * 4 + 3;
    int s_iss = sb_end, slot_i = 0, slot_c = 0;
#define ISSUE_DN() do { STG_ISSUE(s_iss > 0 ? s_iss : 0, slot_i); --s_iss; slot_i = slot_i == NSTG - 1 ? 0 : slot_i + 1; } while (0)
    ISSUE_DN(); ISSUE_DN();
    WAITBAR2();
    f32x16 o0 = {}, o1 = {}; float carry = 0.f; bool done = false;
    for (int sbk = sb_end, step = 0; ; --sbk, ++step) {
        const bool more = sbk > 0;
        ISSUE_DN();
        const LAS unsigned char* cb = sb + slot_c * STG_BYTES + lane * 16;
#pragma unroll
        for (int u = 1; u >= 0; --u) { const int kb = 2 * sbk + u;
            if (kb <= qb && !done) { sub_C(cb + u * 8192, qf, (kb == qb) ? q - 8 * h : 64, h, o0, o1, carry); if (__all(carry < -64.0f)) done = true; } }
        if (lane == 0) flags[(step & 1) * 8 + wave] = (more && !done) ? 1u : 0u;
        WAITBAR2();
        slot_c = slot_c == NSTG - 1 ? 0 : slot_c + 1;
        unsigned any = 0;
#pragma unroll
        for (int w = 0; w < 8; ++w) any |= flags[(step & 1) * 8 + w];
        if (!any) break;
    }
    DRAIN_DMA();
    bf16_t* op = mixed + (tok0 + qb * 32 + q) * DM + 768 + hd * 64;
    store_ot(op, o0, 1.0f, h); store_ot(op + 32, o1, 1.0f, h);
}

constexpr int NB_B = NBATCH * 4 * 32, NB_A = NBATCH * 8 * 16, NB_C = NBATCH * 4 * 32, NB_ITEMS = NB_B + NB_A + NB_C;
__device__ __forceinline__ void attn_phase(unsigned char* ws, int layer, LAS unsigned char* lds) {
    int tid_ = threadIdx.x; asm volatile("" : "+v"(tid_));
    const int tid = tid_, lane = tid & 63, wave = __builtin_amdgcn_readfirstlane(tid >> 6);
    const bf16_t* QK = (const bf16_t*)(ws + WS_QK); const bf16_t* VT = (const bf16_t*)(ws + WS_VT); bf16_t* mixed = (bf16_t*)(ws + WS_ACT);
    const float* tblg = (const float*)(ws + WS_TBL); const float* prm = (const float*)(ws + WS_PRM);
#define UNIF(x_) __uint_as_float(__builtin_amdgcn_readfirstlane(__float_as_uint(x_)))
    const float lam = UNIF(prm[PLAM + layer]), osc = UNIF(1.0f - prm[PLAMI + layer]);
    unsigned* ctr = (unsigned*)(ws + WS_CTL) + layer;
    volatile LAS unsigned* ctl = (volatile LAS unsigned*)(lds + ITEM_OFF);
    unsigned nxt = 0; if (tid == 0) nxt = atomicAdd(ctr, 1u);
    for (;;) {
        if (tid == 0) ctl[0] = nxt;
        __syncthreads();
        const int it = __builtin_amdgcn_readfirstlane((int)ctl[0]);
        if (it >= NB_ITEMS) break;
        if (tid == 0) nxt = atomicAdd(ctr, 1u);
        if (it < NB_B) { const int chunk = 31 - (it >> 5), bh = it & 31, b = bh >> 2, hd = bh & 3;
            blk_B(b, hd, chunk, QK, VT, mixed, lds, tblg, UNIF(exp2f(prm[PRB + 31 * 12 + 8 + hd] * LOG2E)), lam, osc, prm + PSUB + layer * 64, tid, lane, wave); }
        else if (it < NB_B + NB_A) { const int j = it - NB_B; const int chunk = 15 - (j >> 6), bh = j & 63, b = bh >> 3, hd = bh & 7;
            blk_A(b, hd, chunk, QK, VT, mixed, lds, tblg, tid, lane, wave); }
        else { const int j = it - NB_B - NB_A; const int chunk = 31 - (j >> 5), bh = j & 31, b = bh >> 2, hd = bh & 3;
            blk_C(b, hd, chunk, QK, VT, mixed, lds, tid, lane, wave); }
    }
}

#define XB_TMO      128
#define XB_XCNT(j)  (256  + 64 * (j))
#define XB_XSUB(j)  (1280 + 64 * (j))
#define XB_XGEN(j)  (2304 + 64 * (j))
#define XB_TOP      3328
#define XB_TOPGEN   3392
#define XCD_BAR_WORDS 3456
#define XB_SPIN_CAP (1u << 18)

__device__ __forceinline__ unsigned xb_ld(unsigned* p)              { return __hip_atomic_load(p, __ATOMIC_RELAXED, __HIP_MEMORY_SCOPE_AGENT); }
__device__ __forceinline__ unsigned xb_add(unsigned* p, unsigned v) { return __hip_atomic_fetch_add(p, v, __ATOMIC_RELAXED, __HIP_MEMORY_SCOPE_AGENT); }
__device__ __forceinline__ unsigned xb_xcc_id() { return (unsigned)__builtin_amdgcn_s_getreg((3 << 11) | 20) & 0xFu; }
#define XB_SPIN(cond, bar) do { unsigned _sp = 0; while (cond) { __builtin_amdgcn_s_sleep(1); \
    if ((++_sp & 255u) == 0u) { if (xb_ld(&(bar)[XB_TMO])) break; if (_sp > XB_SPIN_CAP) { atomicAdd(&(bar)[XB_TMO], 1u); break; } } } } while (0)

struct XcdBarrier {
    unsigned* bar; unsigned x;
    volatile LAS unsigned* st;
};

__device__ __forceinline__ XcdBarrier xcd_barrier_post(unsigned* bar, volatile LAS unsigned* st) {
    XcdBarrier b; b.bar = bar; b.x = xb_xcc_id(); b.st = st;
    if (threadIdx.x == 0) (void)xb_add(&bar[XB_XCNT(b.x)], 1u);
    return b;
}
__device__ __forceinline__ void xcd_barrier_complete(unsigned* bar, unsigned x, unsigned& nloc, unsigned& nx) {
    const unsigned G = gridDim.x * gridDim.y * gridDim.z;
    unsigned sum, cnt, mine, sp = 0u;
    for (;;) {
        sum = 0u; cnt = 0u; mine = 0u;
#pragma unroll
        for (unsigned j = 0; j < 16; ++j) { const unsigned c = xb_ld(&bar[XB_XCNT(j)]); sum += c; cnt += (c > 0u) ? 1u : 0u; mine = (j == x) ? c : mine; }
        if (sum == G) break;
        __builtin_amdgcn_s_sleep(1);
        if ((++sp & 255u) == 0u) { if (xb_ld(&bar[XB_TMO])) break; if (sp > XB_SPIN_CAP) { atomicAdd(&bar[XB_TMO], 1u); break; } }
    }
    nloc = mine > 0u ? mine : 1u; nx = cnt > 0u ? cnt : 1u;
}

__device__ __forceinline__ void xcd_barrier(const XcdBarrier& b) {
    asm volatile("s_waitcnt vmcnt(0)" ::: "memory");
    __syncthreads();
    if (threadIdx.x == 0) {
        unsigned* bar = b.bar;
        __builtin_amdgcn_s_waitcnt(0);
        unsigned nloc = b.st[0], nx = b.st[1];
        if (nloc == 0u) { xcd_barrier_complete(bar, b.x, nloc, nx); b.st[0] = nloc; b.st[1] = nx; }
        const unsigned old = xb_add(&bar[XB_XSUB(b.x)], 1u);
        const unsigned gen = old / nloc;
        if (old + 1u == (gen + 1u) * nloc) {
            __builtin_amdgcn_fence(__ATOMIC_RELEASE, "agent");
            asm volatile("s_waitcnt vmcnt(0)" ::: "memory");
            const unsigned og = xb_add(&bar[XB_TOP], 1u);
            const unsigned tg = og / nx;
            if (og + 1u == (tg + 1u) * nx) xb_add(&bar[XB_TOPGEN], 1u);
            else XB_SPIN(xb_ld(&bar[XB_TOPGEN]) == tg, bar);
            __builtin_amdgcn_fence(__ATOMIC_ACQUIRE, "agent");
            xb_add(&bar[XB_XGEN(b.x)], 1u);
            asm volatile("s_waitcnt vmcnt(0)" ::: "memory");
        } else {
            XB_SPIN(xb_ld(&bar[XB_XGEN(b.x)]) == gen, bar);
            __builtin_amdgcn_fence(__ATOMIC_ACQUIRE, "agent");
            asm volatile("s_waitcnt vmcnt(0)" ::: "memory");
        }
    }
    __syncthreads();
}

constexpr int CW_BAR = 4096;
#define GRID_SYNC() xcd_barrier(xbar)
#ifndef MK_MULTI
#define MK_MULTI 0
#endif
__global__ void __launch_bounds__(512, 2) mega_fwd(Args a) {
    extern __shared__ __attribute__((aligned(16))) unsigned char lds_raw[];
    LAS unsigned char* lds = (LAS unsigned char*)lds_raw;
    cg::grid_group grid = cg::this_grid();
    const int ph_lo = a.ph_lo, ph_hi = a.ph_hi;
    volatile LAS unsigned* xst = (volatile LAS unsigned*)(lds + ITEM_OFF) + 32;
    if (threadIdx.x < 2) xst[threadIdx.x] = 0u;
    __syncthreads();
    const XcdBarrier xbar = xcd_barrier_post((unsigned*)(a.ws + WS_CTL) + CW_BAR, xst);
    if (ph_lo < 0) {
        { const int tid = threadIdx.x; prologue(a, lds, tid, __builtin_amdgcn_readfirstlane(tid >> 6), tid & 63); }
        if (ph_hi > 0) { asm volatile("s_waitcnt vmcnt(0) lgkmcnt(0)" ::: "memory"); grid.sync();
            if (threadIdx.x < 64) { __builtin_amdgcn_fence(__ATOMIC_ACQUIRE, "agent"); asm volatile("s_waitcnt vmcnt(0)" ::: "memory"); } __syncthreads(); }
    }
    unsigned char* const ws = a.ws; float* const out = a.out; const float* const xin = a.x;
    for (int ph = ph_lo < 0 ? 0 : ph_lo; ph < ph_hi; ++ph) {
        const int l = ph / 7, p = ph % 7, G = gridDim.x;
        bf16_t* xb = (bf16_t*)(ws + WS_XB); bf16_t* act = (bf16_t*)(ws + WS_ACT); u64* ss = (u64*)(ws + WS_SS);
        const bf16_t* Wl = (const bf16_t*)(ws + WS_W) + (size_t)l * WROWS * 1024;
        if (p == 0 || p == 5) {
            const pg8::Gemm g{xb, Wl + (size_t)(p == 0 ? WR_GU1 : WR_GU2) * 1024, MTOK, 2048, 1024};
            pg8::StaticOrder S; S.init(MTOK, 2048, G, (int)blockIdx.x, (l * 7 + (p == 0 ? 0 : 5)) & 1);
            const EpiGU E{act, ss + (size_t)(3 * l + (p == 0 ? 0 : 2)) * MTOK};
            pg8::gemm_phase<EpiGU, pg8::StaticOrder, true, true>(lds, g, S, E);
        } else if (p == 1 || p == 4 || p == 6) {
            const int wr = p == 1 ? WR_D1 : (p == 4 ? WR_O : WR_D2);
            const pg8::Gemm g{act, Wl + (size_t)wr * 1024, MTOK, 1024, 1024};
            pg8::StaticOrder S; S.init(MTOK, 1024, G, (int)blockIdx.x, (l * 7 + (p == 1 ? 1 : (p == 4 ? 4 : 6))) & 1);
            u64* ssn = ss + (size_t)(3 * l + (p == 1 ? 1 : (p == 4 ? 2 : 3))) * MTOK; const float alpha = p == 4 ? 1.0f : 0.5f;
            if (ph == 1) { const EpiRes<1> E{xin, out, xb, ssn, alpha}; pg8::gemm_phase<EpiRes<1>, pg8::StaticOrder, true, true>(lds, g, S, E); }
            else if (ph == 7 * DEPTH - 1) { const EpiRes<2> E{xin, out, xb, ssn, alpha}; pg8::gemm_phase<EpiRes<2>, pg8::StaticOrder, true, true>(lds, g, S, E); }
            else { const EpiRes<0> E{xin, out, xb, ssn, alpha}; pg8::gemm_phase<EpiRes<0>, pg8::StaticOrder, true, true>(lds, g, S, E); }
        } else if (p == 2) {
            const float* prm = (const float*)(ws + WS_PRM);
            { const pg8::Gemm g{xb, Wl + (size_t)WR_QK * 1024, MTOK, 2048, 1024};
              pg8::StaticOrder S; S.init(MTOK, 2048, G, (int)blockIdx.x, (l * 7 + 2) & 1);
              const EpiQK E{(bf16_t*)(ws + WS_QK), ss + (size_t)(3 * l + 1) * MTOK, prm + PGN + l * 256};
              pg8::gemm_phase<EpiQK, pg8::StaticOrder, true, true>(lds, g, S, E); }
            { const pg8::Gemm g{Wl + (size_t)WR_V * 1024, xb, 1024, MTOK, 1024};
              pg8::StaticOrder S; S.init(1024, MTOK, G, (int)blockIdx.x, (l * 7 + 3) & 1);
              const EpiVT E{(bf16_t*)(ws + WS_VT), ss + (size_t)(3 * l + 1) * MTOK};
              pg8::gemm_phase<EpiVT, pg8::StaticOrder, true, true>(lds, g, S, E); }
        } else {
            attn_phase(ws, l, lds);
        }
        if (ph + 1 < ph_hi) GRID_SYNC();
    }
}

extern "C" void kernel_launch(void* const* d_in, const int* in_sizes, int n_in, void* d_out, int out_size, void* d_ws, size_t ws_size, hipStream_t stream) {
    static int grid = 0;
    if (grid == 0) {
        if (n_in != 22 || in_sizes[0] != MTOK * DM || out_size != MTOK * DM || ws_size < WS_END) { fprintf(stderr, "kernel_launch: unexpected shapes (n_in %d, in0 %d, out %d, ws %zu)\n", n_in, n_in > 0 ? in_sizes[0] : -1, out_size, ws_size); grid = -1; return; }
        int dev = 0, cus = 0, per_cu = 0;
        (void)hipGetDevice(&dev); (void)hipDeviceGetAttribute(&cus, hipDeviceAttributeMultiprocessorCount, dev);
        (void)hipFuncSetAttribute((const void*)mega_fwd, hipFuncAttributeMaxDynamicSharedMemorySize, LDS_BYTES);
        if (hipOccupancyMaxActiveBlocksPerMultiprocessor(&per_cu, (const void*)mega_fwd, 512, LDS_BYTES) != hipSuccess || per_cu < 1) per_cu = 1;
        (void)hipGetLastError();
        grid = cus * (per_cu > 1 ? 1 : per_cu);
        if (grid <= 0) grid = 256;
    }
    if (grid < 0) return;
    Args a{};
    const float** f = (const float**)&a;
    for (int i = 0; i < 22; ++i) f[i] = (const float*)d_in[i];
    a.out = (float*)d_out; a.ws = (unsigned char*)d_ws;
    (void)hipMemsetAsync((char*)d_ws + WS_CTL, 0, 65536, stream);
    void* args[] = {&a};
#if MK_MULTI
    for (int ph = -1; ph < 7 * DEPTH; ++ph) { a.ph_lo = ph; a.ph_hi = ph + 1;
        hipError_t e = hipLaunchCooperativeKernel((const void*)mega_fwd, dim3(grid), dim3(512), args, LDS_BYTES, stream);
        if (e != hipSuccess) { fprintf(stderr, "launch failed: %s (grid %d)\n", hipGetErrorString(e), grid); break; } }
#else
    a.ph_lo = -1; a.ph_hi = 7 * DEPTH;
    hipError_t e = hipLaunchCooperativeKernel((const void*)mega_fwd, dim3(grid), dim3(512), args, LDS_BYTES, stream);
    if (e != hipSuccess) fprintf(stderr, "cooperative launch failed: %s (grid %d)\n", hipGetErrorString(e), grid);
#endif
}
```

```cpp
#include <hip/hip_runtime.h>
#include <hip/hip_cooperative_groups.h>
#include <cstdio>
#include <cstdint>
namespace cg = cooperative_groups;
namespace pg8 {
#define PG8_LAS __attribute__((address_space(3)))
typedef unsigned short bf16_t;
typedef short bf16x8 __attribute__((ext_vector_type(8)));
typedef float f32x4 __attribute__((ext_vector_type(4)));
typedef unsigned u32x4 __attribute__((ext_vector_type(4)));
constexpr int BM = 256, BK = 64, HALF = 128, HTB = HALF * BK * 2  , STAGE_BYTES = 8 * HTB, NXCD = 8, WGM = 8;

__host__ __device__ __forceinline__ int lds_byte(int r, int c) { const int st = (r >> 4) * 2 + (c >> 5), rr = r & 15, cc = c & 31, ob = rr * 64 + cc * 2; return st * 1024 + (ob ^ (((ob >> 9) & 1) << 5)); }
__host__ __device__ __forceinline__ void stage_rc(int b, int& R, int& C) { const int st = b / 1024, sb = b % 1024, swz = sb ^ (((sb >> 9) & 1) << 5); R = (st >> 1) * 16 + swz / 64; C = (st & 1) * 32 + (swz % 64) / 2; }
__host__ __device__ __forceinline__ int perm32(int rho) { const int n = rho >> 4, i = rho & 15; return 8 * (i >> 2) + 4 * n + (i & 3); }

struct Unit { int pm, pn; };
struct Gemm { const bf16_t* A; const bf16_t* Bt; int M, N, K; };

struct StaticOrder {
    int nM, nN, nwg, G, c, rev;
    __host__ __device__ void init(int M, int N, int G_, int c_, int rev_ = 0) { nM = M / BM; nN = N / BM; nwg = nM * nN; G = G_; c = c_; rev = (rev_ && nwg % G_ == 0) ? 1 : 0; }
    __host__ __device__ bool next(int i, Unit& u) const {
        if (rev) { if (i >= nwg / G) return false; i = nwg / G - 1 - i; }
        const long L = (long)i * G + c; if (L >= nwg) return false;
        int wgid = (int)L; { const int q = nwg / NXCD, r = nwg % NXCD, xcd = wgid % NXCD, off = wgid / NXCD; wgid = (xcd < r ? xcd * (q + 1) : r * (q + 1) + (xcd - r) * q) + off; }
        const int nig = WGM * nN, gid = wgid / nig, fm = gid * WGM, gsz = (nM - fm) < WGM ? (nM - fm) : WGM;
        u.pm = fm + ((wgid % nig) % gsz); u.pn = (wgid % nig) / gsz; return true;
    }
    __device__ __forceinline__ void a_ready(const Unit&) const {}
    __device__ __forceinline__ void done(const Unit&) const {}
};

__device__ __forceinline__ unsigned cvt_pk_bf16(float lo, float hi) { unsigned r; asm volatile("v_cvt_pk_bf16_f32 %0, %1, %2" : "=v"(r) : "v"(lo), "v"(hi)); return r; }
template <class Epi, class Sched, bool ALIGN_EPI = false, bool SP2 = false>
__device__ __forceinline__ void gemm_phase(PG8_LAS unsigned char* lds, const Gemm g, const Sched& S, const Epi& E) {
    int tid_ = threadIdx.x; asm volatile("" : "+v"(tid_));
    const int tid = tid_, wid = __builtin_amdgcn_readfirstlane(tid >> 6), lane = tid & 63, wr = wid >> 2, wc = wid & 3, fr = lane & 15, fq = lane >> 4;
    const int K = g.K, nt = K / BK;
    unsigned voffA[2], voffB[2];
#pragma unroll
    for (int i = 0; i < 2; ++i) { int R, C; stage_rc(tid * 16 + i * 8192, R, C); const int Rb = Epi::PERM ? ((R & ~31) + perm32(R & 31)) : R;
        voffA[i] = (unsigned)(R * K + C) * 2u; voffB[i] = (unsigned)(Rb * K + C) * 2u; }
    const size_t kstep = (size_t)(BK * 2);
    const size_t hstep = (size_t)HALF * K * 2;
    const size_t tstep = 2 * hstep;
    const unsigned ldsw = (unsigned)wid * 1024u;
    const int aoff = lds_byte(wr * 64 + fr, fq * 8), boff = lds_byte(wc * 32 + fr, fq * 8);
#define PG8_SA(b, h) (((b) * 2 + (h)) * HTB)
#define PG8_SB(b, h) ((4 + (b) * 2 + (h)) * HTB)
#define PG8_STAGE(bufoff, gbase, voff) do { _Pragma("unroll") for (int _i = 0; _i < 2; ++_i) \
        __builtin_amdgcn_global_load_lds((const unsigned*)((const char*)(gbase) + (voff)[_i]), (PG8_LAS unsigned*)(lds + (bufoff) + ldsw + _i * 8192), 16, 0, 0); } while (0)
#define PG8_LDA(dst, b, h) do { _Pragma("unroll") for (int m = 0; m < 4; ++m) _Pragma("unroll") for (int k = 0; k < 2; ++k) dst[m][k] = *(const PG8_LAS bf16x8*)(lds + PG8_SA(b, h) + aoff + m * 2048 + k * 1024); } while (0)
#define PG8_LDB(dst, b, h) do { _Pragma("unroll") for (int n = 0; n < 2; ++n) _Pragma("unroll") for (int k = 0; k < 2; ++k) dst[n][k] = *(const PG8_LAS bf16x8*)(lds + PG8_SB(b, h) + boff + n * 2048 + k * 1024); } while (0)
#define PG8_MMA(ai, bj, At, Bt) do { __builtin_amdgcn_s_setprio(1); _Pragma("unroll") for (int m = 0; m < 4; ++m) _Pragma("unroll") for (int n = 0; n < 2; ++n) _Pragma("unroll") for (int k = 0; k < 2; ++k) \
        acc[ai][bj][m][n] = __builtin_amdgcn_mfma_f32_16x16x32_bf16(Bt[n][k], At[m][k], acc[ai][bj][m][n], 0, 0, 0); __builtin_amdgcn_s_setprio(0); } while (0)
#define PG8_WAIT_V(n) asm volatile("s_waitcnt vmcnt(" #n ")" ::: "memory")
#define PG8_WAIT_L(n) asm volatile("s_waitcnt lgkmcnt(" #n ")" ::: "memory")
#define PG8_BAR __builtin_amdgcn_s_barrier()
#define PG8_SCHED __builtin_amdgcn_sched_barrier(0)
    Unit cur, nxt; int ui = 0;
    if (!S.next(0, cur)) return;
    f32x4 acc[2][2][4][2];
#pragma unroll
    for (int a = 0; a < 2; ++a)
#pragma unroll
        for (int b = 0; b < 2; ++b)
#pragma unroll
            for (int m = 0; m < 4; ++m)
#pragma unroll
                for (int n = 0; n < 2; ++n) acc[a][b][m][n] = (f32x4){0.f, 0.f, 0.f, 0.f};
    bf16x8 At[4][2], B0[2][2], B1[2][2];
    const char* cA = (const char*)g.A + (size_t)cur.pm * tstep; const char* cB = (const char*)g.Bt + (size_t)cur.pn * tstep;
    S.a_ready(cur);
    if constexpr (SP2) {
        PG8_STAGE(PG8_SB(0, 0), cB, voffB); PG8_STAGE(PG8_SB(0, 1), cB + hstep, voffB); PG8_STAGE(PG8_SA(0, 0), cA, voffA); PG8_STAGE(PG8_SA(0, 1), cA + hstep, voffA);
        if (wr == 1) PG8_BAR;
        PG8_WAIT_V(2); PG8_BAR;
        PG8_STAGE(PG8_SB(1, 0), cB + kstep, voffB); PG8_STAGE(PG8_SA(1, 0), cA + kstep, voffA); PG8_STAGE(PG8_SB(1, 1), cB + hstep + kstep, voffB);
        PG8_WAIT_V(6); PG8_BAR;
    } else {
        PG8_STAGE(PG8_SB(0, 0), cB, voffB); PG8_STAGE(PG8_SA(0, 0), cA, voffA); PG8_STAGE(PG8_SB(0, 1), cB + hstep, voffB); PG8_STAGE(PG8_SA(0, 1), cA + hstep, voffA);
        if (wr == 1) PG8_BAR;
        PG8_WAIT_V(4); PG8_BAR;
        PG8_STAGE(PG8_SB(1, 0), cB + kstep, voffB); PG8_STAGE(PG8_SA(1, 0), cA + kstep, voffA); PG8_STAGE(PG8_SB(1, 1), cB + hstep + kstep, voffB);
        PG8_WAIT_V(6); PG8_BAR;
    }
    for (;;) {
        const bool has_next = S.next(ui + 1, nxt);
        const char* nA = has_next ? (const char*)g.A + (size_t)nxt.pm * tstep : cA; const char* nB = has_next ? (const char*)g.Bt + (size_t)nxt.pn * tstep : cB;
        for (int t = 0; t < nt; t += 2) {
            const bool last = (t == nt - 2);
            const char* a1 = cA + (size_t)(t + 1) * kstep;
            const char* a2 = last ? nA : cA + (size_t)(t + 2) * kstep; const char* b2 = last ? nB : cB + (size_t)(t + 2) * kstep;
            const char* a3 = a2 + kstep; const char* b3 = b2 + kstep;
            if (last && has_next) S.a_ready(nxt);
            if constexpr (SP2) {
            PG8_LDB(B0, 0, 0); PG8_LDB(B1, 0, 1); PG8_SCHED; PG8_LDA(At, 0, 0); PG8_STAGE(PG8_SA(1, 1), a1 + hstep, voffA);
            PG8_WAIT_V(8); PG8_WAIT_L(0); PG8_BAR; PG8_MMA(0, 0, At, B0); PG8_MMA(0, 1, At, B1); PG8_BAR; PG8_SCHED;
            PG8_LDA(At, 0, 1); PG8_STAGE(PG8_SB(0, 0), b2, voffB); PG8_STAGE(PG8_SB(0, 1), b2 + hstep, voffB); PG8_STAGE(PG8_SA(0, 0), a2, voffA);
            PG8_WAIT_V(8); PG8_WAIT_L(0); PG8_BAR; PG8_MMA(1, 0, At, B0); PG8_MMA(1, 1, At, B1); PG8_BAR; PG8_SCHED;
            PG8_LDB(B0, 1, 0); PG8_LDB(B1, 1, 1); PG8_SCHED; PG8_LDA(At, 1, 0); PG8_STAGE(PG8_SA(0, 1), a2 + hstep, voffA);
            PG8_WAIT_V(8); PG8_WAIT_L(0); PG8_BAR; PG8_MMA(0, 0, At, B0); PG8_MMA(0, 1, At, B1); PG8_BAR; PG8_SCHED;
            PG8_LDA(At, 1, 1); PG8_STAGE(PG8_SB(1, 0), b3, voffB); PG8_STAGE(PG8_SB(1, 1), b3 + hstep, voffB); PG8_STAGE(PG8_SA(1, 0), a3, voffA);
            PG8_WAIT_V(8); PG8_WAIT_L(0); PG8_BAR; PG8_MMA(1, 0, At, B0); PG8_MMA(1, 1, At, B1); PG8_BAR; PG8_SCHED;
            } else {
            PG8_LDB(B0, 0, 0); PG8_SCHED; PG8_LDA(At, 0, 0); PG8_STAGE(PG8_SA(1, 1), a1 + hstep, voffA);
            PG8_WAIT_L(8); PG8_BAR; PG8_WAIT_L(0); PG8_MMA(0, 0, At, B0); PG8_BAR; PG8_SCHED;
            PG8_LDB(B1, 0, 1); PG8_STAGE(PG8_SB(0, 0), b2, voffB);
            PG8_BAR; PG8_WAIT_L(0); PG8_MMA(0, 1, At, B1); PG8_BAR;
            PG8_LDA(At, 0, 1); PG8_STAGE(PG8_SA(0, 0), a2, voffA);
            PG8_BAR; PG8_WAIT_L(0); PG8_MMA(1, 0, At, B0); PG8_BAR; PG8_SCHED;
            PG8_STAGE(PG8_SB(0, 1), b2 + hstep, voffB);
            PG8_WAIT_V(6); PG8_BAR; PG8_MMA(1, 1, At, B1); PG8_BAR;
            PG8_LDB(B0, 1, 0); PG8_SCHED; PG8_LDA(At, 1, 0); PG8_STAGE(PG8_SA(0, 1), a2 + hstep, voffA);
            PG8_WAIT_L(8); PG8_BAR; PG8_WAIT_L(0); PG8_MMA(0, 0, At, B0); PG8_BAR; PG8_SCHED;
            PG8_LDB(B1, 1, 1); PG8_STAGE(PG8_SB(1, 0), b3, voffB);
            PG8_BAR; PG8_WAIT_L(0); PG8_MMA(0, 1, At, B1); PG8_BAR;
            PG8_LDA(At, 1, 1); PG8_STAGE(PG8_SA(1, 0), a3, voffA);
            PG8_BAR; PG8_WAIT_L(0); PG8_MMA(1, 0, At, B0); PG8_BAR; PG8_SCHED;
            PG8_STAGE(PG8_SB(1, 1), b3 + hstep, voffB);
            PG8_WAIT_V(6); PG8_BAR; PG8_MMA(1, 1, At, B1); PG8_BAR;
            }
        }
        if constexpr (ALIGN_EPI) { if (wr == 0) PG8_BAR; }
        if constexpr (!Epi::AFTER_DRAIN) { E(acc, cur, wr, wc, fr, fq); S.done(cur); }
        if (!has_next) break;
#pragma unroll
        for (int a = 0; a < 2; ++a)
#pragma unroll
            for (int b = 0; b < 2; ++b)
#pragma unroll
                for (int m = 0; m < 4; ++m)
#pragma unroll
                    for (int n = 0; n < 2; ++n) acc[a][b][m][n] = (f32x4){0.f, 0.f, 0.f, 0.f};
        cur = nxt; cA = nA; cB = nB; ++ui;
        if constexpr (ALIGN_EPI) { if (wr == 1) PG8_BAR; }
    }
    PG8_WAIT_V(0);
    if constexpr (!ALIGN_EPI) { if (wr == 0) PG8_BAR; }
    PG8_BAR;
    if constexpr (Epi::AFTER_DRAIN) { E.fused(acc, cur, wr, wc, fr, fq, lds, wid, lane); S.done(cur); }
#undef PG8_SA
#undef PG8_SB
#undef PG8_STAGE
#undef PG8_LDA
#undef PG8_LDB
#undef PG8_MMA
#undef PG8_WAIT_V
#undef PG8_WAIT_L
#undef PG8_BAR
#undef PG8_SCHED
}
}
#define LAS __attribute__((address_space(3)))
typedef pg8::bf16_t bf16_t;
typedef pg8::bf16x8 bf16x8;
typedef pg8::f32x4 f32x4;
typedef pg8::u32x4 u32x4;
typedef float f32x16 __attribute__((ext_vector_type(16)));
typedef unsigned u32x2 __attribute__((ext_vector_type(2)));
constexpr int SEQ = 8192, NBATCH = 8, DM = 1024, MTOK = NBATCH * SEQ, DEPTH = 4;
constexpr float EPS = 1e-6f, LOG2E = 1.4426950408889634f;
constexpr int TBLN = 2176, TOFF = 32, TS = 2192;
constexpr int WROWS = 10240;
constexpr int WR_GU1 = 0, WR_D1 = 2048, WR_QK = 3072, WR_V = 5120, WR_O = 6144, WR_GU2 = 7168, WR_D2 = 9216;
constexpr size_t MiB = 1u << 20;
constexpr size_t WS_CTL = 0, WS_SS = 1 * MiB, WS_TBL = 8 * MiB, WS_W = 9 * MiB, WS_XB = 96 * MiB, WS_ACT = 224 * MiB, WS_QK = 352 * MiB, WS_VT = 608 * MiB, WS_END = 736 * MiB;
constexpr size_t WS_PRM = WS_TBL + 512 * 1024;
constexpr int PGN = 0  , PSUB = 1024, PRB = 1280, PLAM = 1664, PLAMI = 1668;
typedef unsigned long long u64;
constexpr float SS_SCALE = 1048576.0f, SS_INV = 1.0f / (1048576.0f * 1024.0f);
__device__ __forceinline__ float row_rs(const u64* ss, int row) { return __builtin_amdgcn_rsqf((float)ss[row] * SS_INV + 1e-6f); }
constexpr int LDS_BYTES = 132096;
constexpr int N_B_ITEMS = NBATCH * 4 * 256, N_A_ITEMS = NBATCH * 8 * 256, N_C_ITEMS = NBATCH * 4 * 256, N_ITEMS = N_B_ITEMS + N_A_ITEMS + N_C_ITEMS;

typedef float f32x2_t __attribute__((ext_vector_type(2))); typedef __bf16 bf16x2_t __attribute__((ext_vector_type(2)));
__device__ __forceinline__ unsigned pkbf(float lo, float hi) { const f32x2_t v = {lo, hi}; const bf16x2_t b = __builtin_convertvector(v, bf16x2_t); return __builtin_bit_cast(unsigned, b); }
__device__ __forceinline__ float wave_sum(float v) {
#pragma unroll
    for (int o = 1; o < 64; o <<= 1) v += __shfl_xor(v, o);
    return v;
}
__device__ __forceinline__ float ex2(float x) { return __builtin_amdgcn_exp2f(x); }
__device__ __forceinline__ float lg2(float x) { return __builtin_amdgcn_logf(x); }

struct EpiGU {
    static constexpr bool PERM = true, AFTER_DRAIN = false;
    bf16_t* O; const u64* ss;
    __device__ __forceinline__ void operator()(const f32x4 (&acc)[2][2][4][2], const pg8::Unit& u, int wr, int wc, int fr, int fq) const {
        const int row0 = u.pm * 256 + wr * 64 + fr, col0 = u.pn * 128 + wc * 32 + 8 * fq;
        u64 sv[2][4];
#pragma unroll
        for (int ai = 0; ai < 2; ++ai)
#pragma unroll
            for (int m = 0; m < 4; ++m) sv[ai][m] = ss[row0 + ai * 128 + m * 16];
#pragma unroll
        for (int ai = 0; ai < 2; ++ai)
#pragma unroll
            for (int m = 0; m < 4; ++m) {
                const int row = row0 + ai * 128 + m * 16;
                const float r = __builtin_amdgcn_rsqf((float)sv[ai][m] * SS_INV + 1e-6f);
                float h[8];
#pragma unroll
                for (int n = 0; n < 2; ++n)
#pragma unroll
                    for (int i = 0; i < 4; ++i) { const float g = acc[ai][0][m][n][i] * r, uu = acc[ai][1][m][n][i] * r;
                        h[n * 4 + i] = g * uu * __builtin_amdgcn_rcpf(1.0f + ex2(-g * LOG2E)); }
                u32x4 w; w.x = pkbf(h[0], h[1]); w.y = pkbf(h[2], h[3]); w.z = pkbf(h[4], h[5]); w.w = pkbf(h[6], h[7]);
                *(u32x4*)(O + (size_t)row * DM + col0) = w;
            }
    }
};
template <int MODE  > struct EpiRes {
    static constexpr bool PERM = true, AFTER_DRAIN = false;
    const float* x32; float* out; bf16_t* xb; u64* ssn; float alpha;
    __device__ __forceinline__ void operator()(const f32x4 (&acc)[2][2][4][2], const pg8::Unit& u, int wr, int wc, int fr, int fq) const {
        const int row0 = u.pm * 256 + wr * 64 + fr, col0 = u.pn * 256 + wc * 32 + 8 * fq;
        float sq[2][4];
        if (MODE == 1) {
#pragma unroll
            for (int ai = 0; ai < 2; ++ai) { f32x4 b[4][2][2];
#pragma unroll
                for (int m = 0; m < 4; ++m)
#pragma unroll
                    for (int bj = 0; bj < 2; ++bj) { const size_t off = (size_t)(row0 + ai * 128 + m * 16) * DM + col0 + bj * 128;
                        b[m][bj][0] = *(const f32x4*)(x32 + off); b[m][bj][1] = *(const f32x4*)(x32 + off + 4); }
#pragma unroll
                for (int m = 0; m < 4; ++m) { float q = 0.f;
#pragma unroll
                    for (int bj = 0; bj < 2; ++bj) q += emit(b[m][bj][0] + acc[ai][bj][m][0] * alpha, b[m][bj][1] + acc[ai][bj][m][1] * alpha, (size_t)(row0 + ai * 128 + m * 16) * DM + col0 + bj * 128);
                    sq[ai][m] = q; } }
        } else {
            u32x4 w[2][4][2];
#pragma unroll
            for (int ai = 0; ai < 2; ++ai)
#pragma unroll
                for (int m = 0; m < 4; ++m)
#pragma unroll
                    for (int bj = 0; bj < 2; ++bj) w[ai][m][bj] = *(const u32x4*)(xb + (size_t)(row0 + ai * 128 + m * 16) * DM + col0 + bj * 128);
#pragma unroll
            for (int ai = 0; ai < 2; ++ai)
#pragma unroll
                for (int m = 0; m < 4; ++m) { float q = 0.f;
#pragma unroll
                    for (int bj = 0; bj < 2; ++bj) { const u32x4 t = w[ai][m][bj];
                        const f32x4 b0 = {__uint_as_float(t.x << 16), __uint_as_float(t.x & 0xffff0000u), __uint_as_float(t.y << 16), __uint_as_float(t.y & 0xffff0000u)};
                        const f32x4 b1 = {__uint_as_float(t.z << 16), __uint_as_float(t.z & 0xffff0000u), __uint_as_float(t.w << 16), __uint_as_float(t.w & 0xffff0000u)};
                        q += emit(b0 + acc[ai][bj][m][0] * alpha, b1 + acc[ai][bj][m][1] * alpha, (size_t)(row0 + ai * 128 + m * 16) * DM + col0 + bj * 128); }
                    sq[ai][m] = q; }
        }
        if (MODE != 2) {
#pragma unroll
            for (int ai = 0; ai < 2; ++ai)
#pragma unroll
                for (int m = 0; m < 4; ++m) sq[ai][m] += __shfl_xor(sq[ai][m], 16);
#pragma unroll
            for (int ai = 0; ai < 2; ++ai)
#pragma unroll
                for (int m = 0; m < 4; ++m) sq[ai][m] += __shfl_xor(sq[ai][m], 32);
            if (fq == 0) {
#pragma unroll
                for (int ai = 0; ai < 2; ++ai)
#pragma unroll
                    for (int m = 0; m < 4; ++m) atomicAdd(ssn + row0 + ai * 128 + m * 16, (u64)(sq[ai][m] * SS_SCALE + 0.5f)); }
        }
    }
    __device__ __forceinline__ float emit(const f32x4 v0, const f32x4 v1, size_t off) const {
        if (MODE == 2) { *(f32x4*)(out + off) = v0; *(f32x4*)(out + off + 4) = v1; return 0.f; }
        u32x4 w; w.x = pkbf(v0[0], v0[1]); w.y = pkbf(v0[2], v0[3]); w.z = pkbf(v1[0], v1[1]); w.w = pkbf(v1[2], v1[3]);
        *(u32x4*)(xb + off) = w;
        return (v0[0] * v0[0] + v0[1] * v0[1]) + (v0[2] * v0[2] + v0[3] * v0[3]) + (v1[0] * v1[0] + v1[1] * v1[1]) + (v1[2] * v1[2] + v1[3] * v1[3]);
    }
};
struct EpiQK {
    static constexpr bool PERM = true, AFTER_DRAIN = false;
    bf16_t* O; const u64* ss; const float* gains;
    __device__ __forceinline__ void operator()(const f32x4 (&acc)[2][2][4][2], const pg8::Unit& u, int wr, int wc, int fr, int fq) const {
        const int pn = u.pn, row0 = u.pm * 256 + wr * 64 + fr, col0 = pn * 256 + wc * 64 + 8 * fq;
        const float* g = gains + (pn < 2 ? 0 : (pn < 4 ? 64 : (pn == 4 ? 128 : (pn == 5 ? 160 : 192))));
        const int gstep = pn < 4 ? 32 : 0;
        const float osc = (pn < 2 || pn == 6) ? 0.125f * LOG2E : (pn == 4 ? 0.17677669529663687f * LOG2E : 1.0f);
        const float inv_n = pn < 4 ? (1.0f / 64.0f) : (1.0f / 32.0f);
        const float* gp = g + 8 * fq;
        u64 sv[2][4];
#pragma unroll
        for (int ai = 0; ai < 2; ++ai)
#pragma unroll
            for (int m = 0; m < 4; ++m) sv[ai][m] = ss[row0 + ai * 128 + m * 16];
        f32x4 gg[2][2];
#pragma unroll
        for (int bj = 0; bj < 2; ++bj) { gg[bj][0] = *(const f32x4*)(gp + bj * gstep); gg[bj][1] = *(const f32x4*)(gp + bj * gstep + 4); }
#pragma unroll
        for (int ai = 0; ai < 2; ++ai)
#pragma unroll
            for (int m = 0; m < 4; ++m) {
                const int row = row0 + ai * 128 + m * 16;
                const float r = __builtin_amdgcn_rsqf((float)sv[ai][m] * SS_INV + 1e-6f);
                float s0, s1;
                { const f32x4 a = acc[ai][0][m][0] * r, b = acc[ai][0][m][1] * r; s0 = (a[0] * a[0] + a[1] * a[1]) + (a[2] * a[2] + a[3] * a[3]) + (b[0] * b[0] + b[1] * b[1]) + (b[2] * b[2] + b[3] * b[3]); }
                { const f32x4 a = acc[ai][1][m][0] * r, b = acc[ai][1][m][1] * r; s1 = (a[0] * a[0] + a[1] * a[1]) + (a[2] * a[2] + a[3] * a[3]) + (b[0] * b[0] + b[1] * b[1]) + (b[2] * b[2] + b[3] * b[3]); }
                if (pn < 4) { s0 += s1; s1 = s0; }
                s0 += __shfl_xor(s0, 16); s1 += __shfl_xor(s1, 16); s0 += __shfl_xor(s0, 32); s1 += __shfl_xor(s1, 32);
                float rn0 = osc * r, rn1 = osc * r;
                if (pn < 6) { rn0 *= __builtin_amdgcn_rsqf(s0 * inv_n + EPS); rn1 *= __builtin_amdgcn_rsqf(s1 * inv_n + EPS); }
#pragma unroll
                for (int bj = 0; bj < 2; ++bj) { const float rn = bj ? rn1 : rn0;
                    const f32x4 y0 = acc[ai][bj][m][0] * gg[bj][0] * rn, y1 = acc[ai][bj][m][1] * gg[bj][1] * rn;
                    u32x4 w; w.x = pkbf(y0[0], y0[1]); w.y = pkbf(y0[2], y0[3]); w.z = pkbf(y1[0], y1[1]); w.w = pkbf(y1[2], y1[3]);
                    *(u32x4*)(O + (size_t)row * 2048 + col0 + 32 * bj) = w; }
            }
    }
};
struct EpiVT {
    static constexpr bool PERM = true, AFTER_DRAIN = false;
    bf16_t* O; const u64* ss;
    __device__ __forceinline__ void operator()(const f32x4 (&acc)[2][2][4][2], const pg8::Unit& u, int wr, int wc, int fr, int fq) const {
        const int row0 = u.pm * 256 + wr * 64 + fr, col0 = u.pn * 256 + wc * 32 + 8 * fq;
        f32x4 r[2][2];
#pragma unroll
        for (int bj = 0; bj < 2; ++bj)
#pragma unroll
            for (int n = 0; n < 2; ++n) {
#pragma unroll
                for (int i = 0; i < 4; ++i) r[bj][n][i] = row_rs(ss, col0 + bj * 128 + 4 * n + i); }
#pragma unroll
        for (int ai = 0; ai < 2; ++ai)
#pragma unroll
            for (int m = 0; m < 4; ++m) {
                const int row = row0 + ai * 128 + m * 16;
#pragma unroll
                for (int bj = 0; bj < 2; ++bj) { const f32x4 y0 = acc[ai][bj][m][0] * r[bj][0], y1 = acc[ai][bj][m][1] * r[bj][1];
                    u32x4 w; w.x = pkbf(y0[0], y0[1]); w.y = pkbf(y0[2], y0[3]); w.z = pkbf(y1[0], y1[1]); w.w = pkbf(y1[2], y1[3]);
                    *(u32x4*)(O + (size_t)row * MTOK + col0 + bj * 128) = w; }
            }
    }
};

struct Args {
    const float *x, *rel_bias, *ffn1_norm, *ffn1_wg, *ffn1_wu, *ffn1_wd, *mix_norm, *w_in, *qna, *kna, *qnb, *knb, *lq1, *lk1, *lq2, *lk2, *subln, *w_out, *ffn2_norm, *ffn2_wg, *ffn2_wu, *ffn2_wd;
    float* out; unsigned char* ws; int ph_lo, ph_hi;
};

struct TrItem { const float* src; const float* gain; bf16_t* dst; int Nsrc, c0, k0; };
__device__ __forceinline__ void tr_load(const TrItem& d, float (&tv)[32], int lane) {
#pragma unroll
    for (int i = 0; i < 32; ++i) tv[i] = d.src[(size_t)(d.k0 + 2 * i + (lane >> 5)) * d.Nsrc + d.c0 + (lane & 31)];
}
__device__ __forceinline__ void tr_store(const TrItem& d, float (&tv)[32], LAS float* scr, int lane) {
    if (d.gain) {
#pragma unroll
        for (int i = 0; i < 32; ++i) tv[i] *= d.gain[d.k0 + 2 * i + (lane >> 5)]; }
#pragma unroll
    for (int i = 0; i < 32; ++i) scr[(2 * i + (lane >> 5)) * 33 + (lane & 31)] = tv[i];
    asm volatile("s_waitcnt lgkmcnt(0)" ::: "memory");
    const int c = lane & 7;
#pragma unroll
    for (int j = 0; j < 4; ++j) { const int n = (lane >> 3) + 8 * j; const LAS float* s = scr + (8 * c) * 33 + n;
        u32x4 o; o.x = pkbf(s[0 * 33], s[1 * 33]); o.y = pkbf(s[2 * 33], s[3 * 33]); o.z = pkbf(s[4 * 33], s[5 * 33]); o.w = pkbf(s[6 * 33], s[7 * 33]);
        *(u32x4*)(d.dst + (size_t)n * 1024 + d.k0 + 8 * c) = o; }
    asm volatile("s_waitcnt lgkmcnt(0)" ::: "memory");
}
__device__ __forceinline__ int t5_bucket(int dist) {
    if (dist < 16) return dist;
    const int large = 16 + (int)(logf((float)dist / 16.0f) / 4.852030263919617f * 16.0f);
    return large < 31 ? large : 31;
}
__device__ __forceinline__ void prologue(const Args& a, LAS unsigned char* lds, int tid, int wave, int lane) {
    const int gw = blockIdx.x * 8 + wave, NGW = gridDim.x * 8;
    unsigned char* ws = a.ws;
    bf16_t* Wb = (bf16_t*)(ws + WS_W);
    LAS float* scr = (LAS float*)(lds + wave * 16384);
#define TR_DECODE(d_, it_) do { const int l = (it_) / 5120, r = (it_) % 5120, rb = r >> 4; (d_).k0 = (r & 15) * 64; (d_).Nsrc = 1024; (d_).gain = nullptr; \
        if (rb < 64 || (rb >= 224 && rb < 288)) { const bool second = rb >= 224; const int n = (second ? rb - 224 : rb) * 32, pn = n >> 8, bj = (n >> 7) & 1, j = n & 127; \
            (d_).src = (second ? (bj ? a.ffn2_wu : a.ffn2_wg) : (bj ? a.ffn1_wu : a.ffn1_wg)) + (size_t)l * 1048576; (d_).c0 = 128 * pn + j; (d_).gain = (second ? a.ffn2_norm : a.ffn1_norm) + l * 1024; } \
        else if (rb < 96) { (d_).src = a.ffn1_wd + (size_t)l * 1048576; (d_).c0 = (rb - 64) * 32; } \
        else if (rb < 160) { const int n = (rb - 96) * 32, pn = n >> 8, bj = (n >> 7) & 1, wc = (n >> 5) & 3, f = 256 * pn + 64 * wc + 32 * bj; \
            (d_).c0 = f < 1024 ? f : (f < 1536 ? 1536 + (f - 1024) : 2304 + (f - 1536)); (d_).src = a.w_in + (size_t)l * 3145728; (d_).Nsrc = 3072; (d_).gain = a.mix_norm + l * 1024; } \
        else if (rb < 192) { const int g = (rb - 160) * 32; (d_).c0 = g < 512 ? 1024 + g : (g < 768 ? 2048 + (g - 512) : 2816 + (g - 768)); (d_).src = a.w_in + (size_t)l * 3145728; (d_).Nsrc = 3072; (d_).gain = a.mix_norm + l * 1024; } \
        else if (rb < 224) { (d_).src = a.w_out + (size_t)l * 1048576; (d_).c0 = (rb - 192) * 32; } \
        else { (d_).src = a.ffn2_wd + (size_t)l * 1048576; (d_).c0 = (rb - 288) * 32; } \
        (d_).dst = Wb + ((size_t)l * WROWS + rb * 32) * 1024; } while (0)
    if (gw < DEPTH * 5120) {
        TrItem cur; float tv[32]; int it = gw; TR_DECODE(cur, it); tr_load(cur, tv, lane);
        for (;;) {
            const int nx = it + NGW; const bool has = nx < DEPTH * 5120; TrItem nxt = cur; float tn[32];
            if (has) { TR_DECODE(nxt, nx); tr_load(nxt, tn, lane); }
            tr_store(cur, tv, scr, lane);
            if (!has) break;
            cur = nxt; it = nx;
#pragma unroll
            for (int i = 0; i < 32; ++i) tv[i] = tn[i];
        }
    }
    bf16_t* xb = (bf16_t*)(ws + WS_XB); u64* ss = (u64*)(ws + WS_SS);
    for (int rb4 = gw * 4; rb4 < MTOK; rb4 += NGW * 4) {
        f32x4 v[4][4]; float sm[4];
#pragma unroll
        for (int r = 0; r < 4; ++r) { const f32x4* xr = (const f32x4*)(a.x + (size_t)(rb4 + r) * DM) + lane;
#pragma unroll
            for (int j = 0; j < 4; ++j) v[r][j] = xr[64 * j]; }
#pragma unroll
        for (int r = 0; r < 4; ++r) { float s = 0.f;
#pragma unroll
            for (int j = 0; j < 4; ++j) s += (v[r][j][0] * v[r][j][0] + v[r][j][1] * v[r][j][1]) + (v[r][j][2] * v[r][j][2] + v[r][j][3] * v[r][j][3]);
            sm[r] = s; }
#pragma unroll
        for (int o = 1; o < 64; o <<= 1) {
#pragma unroll
            for (int r = 0; r < 4; ++r) sm[r] += __shfl_xor(sm[r], o); }
#pragma unroll
        for (int r = 0; r < 4; ++r) { u32x2* o8 = (u32x2*)(xb + (size_t)(rb4 + r) * DM) + lane;
#pragma unroll
            for (int j = 0; j < 4; ++j) { u32x2 w; w.x = pkbf(v[r][j][0], v[r][j][1]); w.y = pkbf(v[r][j][2], v[r][j][3]); o8[64 * j] = w; }
            if (lane == 0) ss[rb4 + r] = (u64)(sm[r] * SS_SCALE + 0.5f); }
    }
    const int gt = blockIdx.x * 512 + tid, NGT = gridDim.x * 512;
    for (int i = gt; i < 12 * MTOK; i += NGT) ss[MTOK + i] = 0ull;
    if (gt < 64) ((unsigned*)(ws + WS_CTL))[gt] = 0u;
    float* prm = (float*)(ws + WS_PRM);
    if (gt < 1024) { const int l = gt >> 8, j = gt & 255;
        prm[PGN + gt] = j < 64 ? a.qna[l * 64 + j] : (j < 128 ? a.kna[l * 64 + j - 64] : (j < 160 ? a.qnb[l * 32 + j - 128] : (j < 192 ? a.knb[l * 32 + j - 160] : 1.0f))); }
    if (gt < 256) prm[PSUB + gt] = a.subln[gt];
    if (gt < 384) prm[PRB + gt] = a.rel_bias[gt];
    if (gt < DEPTH) { float d1 = 0.f, d2 = 0.f;
        for (int i = 0; i < 32; ++i) { d1 += a.lq1[gt * 32 + i] * a.lk1[gt * 32 + i]; d2 += a.lq2[gt * 32 + i] * a.lk2[gt * 32 + i]; }
        const float lam_init = 0.8f - 0.6f * expf(-0.3f * (float)gt);
        prm[PLAM + gt] = expf(d1) - expf(d2) + lam_init; prm[PLAMI + gt] = lam_init; }
    float* tb = (float*)(ws + WS_TBL);
    for (int i = gt; i < 12 * 4 * TS; i += NGT) {
        const int h = i / (4 * TS), xx = (i % TS) + ((i / TS) & 3), dist = (TBLN - 1 - xx) - TOFF;
        float val = -1e30f;
        if (xx < TBLN && dist >= 0) {
            const float bias = a.rel_bias[t5_bucket(dist) * 12 + h] * LOG2E;
            if (h >= 8) val = bias;
            else { const int mult = (dist <= 128 ? 1 : 0) + (((dist & 3) == 0 && dist <= 512) ? 1 : 0) + (((dist & 15) == 0 && dist <= 2048) ? 1 : 0);
                if (mult > 0) val = bias + (mult == 1 ? 0.f : (mult == 2 ? 1.0f : 1.5849625007211562f)); }
        }
        tb[i] = val;
    }
}

__device__ __forceinline__ f32x16 mfma32(bf16x8 a, bf16x8 b, f32x16 c) { return __builtin_amdgcn_mfma_f32_32x32x16_bf16(a, b, c, 0, 0, 0); }
#define CIDX(i) (16 * ((i) >> 3) + ((i) & 7))
__device__ __forceinline__ void pack_p(const f32x16& p, bf16x8& lo, bf16x8& hi) {
    u32x4 a, b; a.x = pkbf(p[0], p[1]); a.y = pkbf(p[2], p[3]); a.z = pkbf(p[4], p[5]); a.w = pkbf(p[6], p[7]);
    b.x = pkbf(p[8], p[9]); b.y = pkbf(p[10], p[11]); b.z = pkbf(p[12], p[13]); b.w = pkbf(p[14], p[15]);
    lo = __builtin_bit_cast(bf16x8, a); hi = __builtin_bit_cast(bf16x8, b);
}
__device__ __forceinline__ void store_ot(bf16_t* dst, const f32x16& o, float sc, int h) {
#pragma unroll
    for (int c = 0; c < 4; ++c) { u32x2 w; w.x = pkbf(o[4 * c] * sc, o[4 * c + 1] * sc); w.y = pkbf(o[4 * c + 2] * sc, o[4 * c + 3] * sc); *(u32x2*)(dst + 8 * c + 4 * h) = w; }
}

constexpr int SBUF_OFF = 4 * TS * 4  , STG_BYTES = 16384, NSTG = 3, ITEM_OFF = 131072  ;
static_assert(ITEM_OFF + 1024 <= LDS_BYTES && SBUF_OFF % 16 == 0 && SBUF_OFF + NSTG * STG_BYTES <= ITEM_OFF, "LDS map");
struct Stage { const bf16_t* ksrc; const bf16_t* vsrc; unsigned kdst, vdst; };
__device__ __forceinline__ Stage make_stage(int tid, const bf16_t* QK, const bf16_t* VT, size_t tok0, int kcol, int vrow) {
    Stage st; const int w = __builtin_amdgcn_readfirstlane(tid >> 6), l = tid & 63, h = l >> 5, r5 = l & 31, pr = (r5 & ~12) | ((r5 & 4) << 1) | ((r5 & 8) >> 1), u = w >> 2;
    st.ksrc = QK + (tok0 + 32 * u + pr) * 2048 + kcol + 16 * (w & 3) + 8 * h; st.kdst = (unsigned)(u * 8192 + (w & 3) * 1024);
    st.vsrc = VT + (size_t)(vrow + 32 * ((w >> 1) & 1) + r5) * MTOK + tok0 + 32 * u + 16 * (w & 1) + 8 * h; st.vdst = (unsigned)(u * 8192 + 4096 + (w & 3) * 1024);
    return st;
}
#define STG_ISSUE(idx_, slot_) do { LAS unsigned char* d_ = sb + (slot_) * STG_BYTES; \
    __builtin_amdgcn_global_load_lds((const unsigned*)(st.ksrc + (size_t)(idx_) * (64 * 2048)), (LAS unsigned*)(d_ + st.kdst), 16, 0, 0); \
    __builtin_amdgcn_global_load_lds((const unsigned*)(st.vsrc + (idx_) * 64), (LAS unsigned*)(d_ + st.vdst), 16, 0, 0); } while (0)
#define WAITBAR2() asm volatile("s_waitcnt vmcnt(2) lgkmcnt(0)\n\ts_barrier" ::: "memory")
#define DRAIN_DMA() asm volatile("s_waitcnt vmcnt(0)" ::: "memory")
#define FRAG_LOAD(cb_) do { LOADK(kf, cb_); LOADV(vf, cb_); } while (0)
#define LOADK(kf_, cb_) do { _Pragma("unroll") for (int s_ = 0; s_ < 4; ++s_) kf_[s_] = *(const LAS bf16x8*)((cb_) + s_ * 1024); } while (0)
#define LOADV(vf_, cb_) do { _Pragma("unroll") for (int d_ = 0; d_ < 2; ++d_) _Pragma("unroll") for (int s_ = 0; s_ < 2; ++s_) vf_[d_][s_] = *(const LAS bf16x8*)((cb_) + 4096 + (d_ * 2 + s_) * 1024); } while (0)
#define LOADT(t_, tp_) do { const f32x4 a_ = *(const LAS f32x4*)(tp_), b_ = *(const LAS f32x4*)((tp_) + 16), c_ = *(const LAS f32x4*)((tp_) + 64), d_ = *(const LAS f32x4*)((tp_) + 80); \
    t_ = (f32x16){a_[0], a_[1], a_[2], a_[3], b_[0], b_[1], b_[2], b_[3], c_[0], c_[1], c_[2], c_[3], d_[0], d_[1], d_[2], d_[3]}; } while (0)
#define LOAD_HEAD_TABLE(hidx_) do { const u32x4* g4_ = (const u32x4*)(tblg + (size_t)(hidx_) * 4 * TS); LAS u32x4* t4_ = (LAS u32x4*)lds; u32x4 v_[5]; \
    _Pragma("unroll") for (int j_ = 0; j_ < 5; ++j_) { const int i_ = j_ * 512 + tid; if (i_ < TS) v_[j_] = g4_[i_]; } \
    _Pragma("unroll") for (int j_ = 0; j_ < 5; ++j_) { const int i_ = j_ * 512 + tid; if (i_ < TS) t4_[i_] = v_[j_]; } } while (0)
#define LANE_TBL() ((const LAS unsigned char*)lds + (((TBLN - 1 - TOFF) - q + 8 * h) & 3) * (TS * 4) + ((((TBLN - 1 - TOFF) - q + 8 * h) & ~3)) * 4)
#define SCHED_FENCE() __builtin_amdgcn_sched_barrier(0)

__device__ __forceinline__ void sm_A(f32x16& sc, float& l, bf16x8& p0, bf16x8& p1) {
#pragma unroll
    for (int i = 0; i < 16; ++i) { const float p = ex2(sc[i]); sc[i] = p; l += p; }
    pack_p(sc, p0, p1);
}
__device__ __forceinline__ void pv4(const bf16x8 (&vf)[2][2], bf16x8 p0, bf16x8 p1, f32x16& o0, f32x16& o1) {
    o0 = mfma32(vf[0][0], p0, o0); o1 = mfma32(vf[1][0], p0, o1); o0 = mfma32(vf[0][1], p1, o0); o1 = mfma32(vf[1][1], p1, o1);
}
__device__ __forceinline__ void sub_A(const bf16x8 (&kf)[4], const bf16x8 (&vf)[2][2], const bf16x8 (&qf)[4], f32x16 sc  , f32x16& o0, f32x16& o1, float& l) {
#pragma unroll
    for (int s = 0; s < 4; ++s) sc = mfma32(kf[s], qf[s], sc);
    bf16x8 p0, p1; sm_A(sc, l, p0, p1);
    pv4(vf, p0, p1, o0, o1);
}
__device__ __forceinline__ void blk_A(int b, int hd, int chunk  , const bf16_t* QK, const bf16_t* VT, bf16_t* mixed, LAS unsigned char* lds, const float* tblg, int tid, int lane, int wave) {
    const int q = lane & 31, h = lane >> 5, qbA = chunk * 16 + wave, qbB = qbA + 8;
    LOAD_HEAD_TABLE(hd);
    const size_t tok0 = (size_t)b * SEQ;
    bf16x8 qfA[4], qfB[4];
    { const bf16_t* Qp = QK + (tok0 + qbA * 32 + q) * 2048 + hd * 64 + 8 * h;
#pragma unroll
      for (int s = 0; s < 4; ++s) { qfA[s] = *(const bf16x8*)(Qp + 16 * s); qfB[s] = *(const bf16x8*)(Qp + (size_t)8 * 32 * 2048 + 16 * s); } }
    const Stage st = make_stage(tid, QK, VT, tok0, 512 + hd * 64, hd * 64);
    LAS unsigned char* sb = lds + SBUF_OFF;
    const int sb_end = chunk * 8 + 7, sb_lo = chunk * 8 > 32 ? chunk * 8 - 32 : 0;
    int s_iss = sb_lo, slot_i = 0, slot_c = 0;
#define ISSUE_UP() do { STG_ISSUE(s_iss < sb_end ? s_iss : sb_end, slot_i); ++s_iss; slot_i = slot_i == NSTG - 1 ? 0 : slot_i + 1; } while (0)
    ISSUE_UP(); ISSUE_UP();
    WAITBAR2();
    f32x16 oA0 = {}, oA1 = {}, oB0 = {}, oB1 = {}; float lA = 0.f, lB = 0.f;
    const LAS unsigned char* tb = LANE_TBL();
    for (int sbk = sb_lo; sbk <= sb_end; ++sbk) {
        ISSUE_UP();
        const LAS unsigned char* cb = sb + slot_c * STG_BYTES + lane * 16;
#pragma unroll
        for (int u = 0; u < 2; ++u) {
            const int kb = 2 * sbk + u; const bool cA = kb <= qbA && kb + 64 >= qbA, cB = kb <= qbB && kb + 64 >= qbB;
            if (cA || cB) {
                bf16x8 kf[4], vf[2][2];
                LOADK(kf, cb + u * 8192); LOADV(vf, cb + u * 8192);
                if (cA) { f32x16 tA; LOADT(tA, tb - (qbA - kb) * 128); SCHED_FENCE(); sub_A(kf, vf, qfA, tA, oA0, oA1, lA); }
                if (cB) { f32x16 tB; LOADT(tB, tb - (qbB - kb) * 128); SCHED_FENCE(); sub_A(kf, vf, qfB, tB, oB0, oB1, lB); }
            }
        }
        WAITBAR2();
        slot_c = slot_c == NSTG - 1 ? 0 : slot_c + 1;
    }
    DRAIN_DMA();
    lA += __shfl_xor(lA, 32); lB += __shfl_xor(lB, 32);
    const float invA = 1.0f / lA, invB = 1.0f / lB;
    bf16_t* op = mixed + (tok0 + qbA * 32 + q) * DM + hd * 64;
    store_ot(op, oA0, invA, h); store_ot(op + 32, oA1, invA, h);
    op += (size_t)8 * 32 * DM;
    store_ot(op, oB0, invB, h); store_ot(op + 32, oB1, invB, h);
}

__device__ __forceinline__ void sub_B(const bf16x8 (&kf)[4], const bf16x8 (&vf)[2][2], const bf16x8 (&qf)[4], const f32x16& t  , f32x16& oa0, f32x16& oa1, f32x16& ob0, f32x16& ob1, float& la, float& lb) {
    f32x16 sa = mfma32(kf[0], qf[0], t); f32x16 sb2 = mfma32(kf[2], qf[2], t); sa = mfma32(kf[1], qf[1], sa); sb2 = mfma32(kf[3], qf[3], sb2);
    SCHED_FENCE();
    bf16x8 pa0, pa1, pb0, pb1;
    sm_A(sa, la, pa0, pa1);
    SCHED_FENCE();
    pv4(vf, pa0, pa1, oa0, oa1);
    SCHED_FENCE();
    sm_A(sb2, lb, pb0, pb1);
    SCHED_FENCE();
    pv4(vf, pb0, pb1, ob0, ob1);
}
#define EXP4(S_, b_) do { S_[b_] = ex2(S_[b_]); S_[(b_) + 1] = ex2(S_[(b_) + 1]); S_[(b_) + 2] = ex2(S_[(b_) + 2]); S_[(b_) + 3] = ex2(S_[(b_) + 3]); } while (0)
#define SUM16(S_, l_) do { l_ += ((S_[0] + S_[1]) + (S_[2] + S_[3])) + ((S_[4] + S_[5]) + (S_[6] + S_[7])) + ((S_[8] + S_[9]) + (S_[10] + S_[11])) + ((S_[12] + S_[13]) + (S_[14] + S_[15])); } while (0)
__device__ __forceinline__ void step_B(const bool FAR, const LAS unsigned char* cb, const LAS unsigned char* tp0, const LAS unsigned char* tp1, const bf16x8 (&qf)[4],
                                       f32x16& oa0, f32x16& oa1, f32x16& ob0, f32x16& ob1, float& la, float& lb) {
    bf16x8 kfA[4], vfA[2][2], kfB[4], vfB[2][2]; f32x16 tA, tB;
    LOADK(kfA, cb); if (!FAR) LOADT(tA, tp0); LOADV(vfA, cb);
    SCHED_FENCE();
    f32x16 S0, S1;
    if (FAR) { S0 = mfma32(kfA[0], qf[0], f32x16{}); S1 = mfma32(kfA[2], qf[2], f32x16{}); }
    else { S0 = mfma32(kfA[0], qf[0], tA); S1 = mfma32(kfA[2], qf[2], tA); }
    S0 = mfma32(kfA[1], qf[1], S0); S1 = mfma32(kfA[3], qf[3], S1);
    kfB[0] = *(const LAS bf16x8*)(cb + 8192); kfB[1] = *(const LAS bf16x8*)(cb + 8192 + 1024); if (!FAR) LOADT(tB, tp1);
    SCHED_FENCE();
    bf16x8 p0, p1, r0, r1;
    f32x16 S2; if (FAR) S2 = mfma32(kfB[0], qf[0], f32x16{}); else S2 = mfma32(kfB[0], qf[0], tB);
    EXP4(S0, 0); EXP4(S0, 4); SCHED_FENCE();
    S2 = mfma32(kfB[1], qf[1], S2); EXP4(S0, 8); EXP4(S0, 12); SCHED_FENCE();
    SUM16(S0, la); pack_p(S0, p0, p1); SCHED_FENCE();
    f32x16 tB2; kfB[2] = *(const LAS bf16x8*)(cb + 8192 + 2048); kfB[3] = *(const LAS bf16x8*)(cb + 8192 + 3072); if (!FAR) LOADT(tB2, tp1);
    oa0 = mfma32(vfA[0][0], p0, oa0); EXP4(S1, 0); SCHED_FENCE();
    oa1 = mfma32(vfA[1][0], p0, oa1); EXP4(S1, 4); SCHED_FENCE();
    oa0 = mfma32(vfA[0][1], p1, oa0); EXP4(S1, 8); SCHED_FENCE();
    oa1 = mfma32(vfA[1][1], p1, oa1); EXP4(S1, 12); SCHED_FENCE();
    f32x16 S3; if (FAR) S3 = mfma32(kfB[2], qf[2], f32x16{}); else S3 = mfma32(kfB[2], qf[2], tB2);
    SUM16(S1, lb); SCHED_FENCE();
    S3 = mfma32(kfB[3], qf[3], S3); pack_p(S1, r0, r1); SCHED_FENCE();
    LOADV(vfB, cb + 8192);
    ob0 = mfma32(vfA[0][0], r0, ob0); EXP4(S2, 0); SCHED_FENCE();
    ob1 = mfma32(vfA[1][0], r0, ob1); EXP4(S2, 4); SCHED_FENCE();
    ob0 = mfma32(vfA[0][1], r1, ob0); EXP4(S2, 8); SCHED_FENCE();
    ob1 = mfma32(vfA[1][1], r1, ob1); EXP4(S2, 12); SCHED_FENCE();
    SUM16(S2, la); pack_p(S2, p0, p1); SCHED_FENCE();
    oa0 = mfma32(vfB[0][0], p0, oa0); EXP4(S3, 0); SCHED_FENCE();
    oa1 = mfma32(vfB[1][0], p0, oa1); EXP4(S3, 4); SCHED_FENCE();
    oa0 = mfma32(vfB[0][1], p1, oa0); EXP4(S3, 8); SCHED_FENCE();
    oa1 = mfma32(vfB[1][1], p1, oa1); EXP4(S3, 12); SCHED_FENCE();
    SUM16(S3, lb); pack_p(S3, r0, r1); SCHED_FENCE();
    ob0 = mfma32(vfB[0][0], r0, ob0); ob1 = mfma32(vfB[1][0], r0, ob1); ob0 = mfma32(vfB[0][1], r1, ob0); ob1 = mfma32(vfB[1][1], r1, ob1);
}
__device__ __forceinline__ void blk_B(int b, int hd, int chunk, const bf16_t* QK, const bf16_t* VT, bf16_t* mixed, LAS unsigned char* lds, const float* tblg, float wfar, float lam, float osc, const float* subln, int tid, int lane, int wave) {
    const int q = lane & 31, h = lane >> 5, qb = chunk * 8 + wave;
    LOAD_HEAD_TABLE(8 + hd);
    const size_t tok0 = (size_t)b * SEQ;
    const bf16_t* Qp = QK + (tok0 + qb * 32 + q) * 2048 + 1024 + hd * 64 + 8 * h;
    bf16x8 qf[4];
#pragma unroll
    for (int s = 0; s < 4; ++s) qf[s] = *(const bf16x8*)(Qp + 16 * s);
    const Stage st = make_stage(tid, QK, VT, tok0, 1280 + hd * 64, 512 + hd * 64);
    LAS unsigned char* sb = lds + SBUF_OFF;
    const int sb_end = chunk * 4 + 3;
    int s_iss = 0, slot_i = 0, slot_c = 0;
    ISSUE_UP(); ISSUE_UP();
    WAITBAR2();
    f32x16 oa0 = {}, oa1 = {}, ob0 = {}, ob1 = {}; float la = 0.f, lb = 0.f; bool scaled = false;
    const LAS unsigned char* tb = LANE_TBL();
    for (int sbk = 0; sbk <= sb_end; ++sbk) {
        ISSUE_UP();
        const LAS unsigned char* cb = sb + slot_c * STG_BYTES + lane * 16;
        const int kb0 = 2 * sbk, kb1 = kb0 + 1; const bool c0 = kb0 <= qb, c1 = kb1 <= qb;
        if (c0 && c1) {
            const bool far = qb - kb1 >= 49;
            if (!far && !scaled) { scaled = true;
#pragma unroll
                for (int i = 0; i < 16; ++i) { oa0[i] *= wfar; oa1[i] *= wfar; ob0[i] *= wfar; ob1[i] *= wfar; }
                la *= wfar; lb *= wfar; }
            const int d0 = qb - kb0 < 64 ? qb - kb0 : 64, d1 = qb - kb1 < 64 ? qb - kb1 : 64;
            step_B(far, cb, tb - d0 * 128, tb - d1 * 128, qf, oa0, oa1, ob0, ob1, la, lb);
        } else if (c0) {
            bf16x8 kfA[4], vfA[2][2]; f32x16 tA;
            const int d0 = qb - kb0 < 64 ? qb - kb0 : 64;
            LOADK(kfA, cb); LOADT(tA, tb - d0 * 128); LOADV(vfA, cb);
            SCHED_FENCE();
            sub_B(kfA, vfA, qf, tA, oa0, oa1, ob0, ob1, la, lb);
        }
        WAITBAR2();
        slot_c = slot_c == NSTG - 1 ? 0 : slot_c + 1;
    }
    DRAIN_DMA();
    la += __shfl_xor(la, 32); lb += __shfl_xor(lb, 32);
    const float ia = 1.0f / la, ib = lam / lb;
    float sq = 0.f;
#pragma unroll
    for (int i = 0; i < 16; ++i) { oa0[i] = oa0[i] * ia - ob0[i] * ib; oa1[i] = oa1[i] * ia - ob1[i] * ib; sq += oa0[i] * oa0[i] + oa1[i] * oa1[i]; }
    sq += __shfl_xor(sq, 32);
    const float rn = __builtin_amdgcn_rsqf(sq * (1.0f / 64.0f) + EPS) * osc;
    bf16_t* op = mixed + (tok0 + qb * 32 + q) * DM + 512 + hd * 64;
#pragma unroll
    for (int c = 0; c < 4; ++c) { const f32x4 g0 = *(const f32x4*)(subln + 8 * c + 4 * h), g1 = *(const f32x4*)(subln + 32 + 8 * c + 4 * h);
        u32x2 w; w.x = pkbf(oa0[4 * c] * rn * g0[0], oa0[4 * c + 1] * rn * g0[1]); w.y = pkbf(oa0[4 * c + 2] * rn * g0[2], oa0[4 * c + 3] * rn * g0[3]); *(u32x2*)(op + 8 * c + 4 * h) = w;
        w.x = pkbf(oa1[4 * c] * rn * g1[0], oa1[4 * c + 1] * rn * g1[1]); w.y = pkbf(oa1[4 * c + 2] * rn * g1[2], oa1[4 * c + 3] * rn * g1[3]); *(u32x2*)(op + 32 + 8 * c + 4 * h) = w; }
}

__device__ __forceinline__ void sub_C(const LAS unsigned char* cb, const bf16x8 (&qf)[4], int kq, int h, f32x16& o0, f32x16& o1, float& carry) {
    bf16x8 kf[4], vf[2][2]; FRAG_LOAD(cb);
    f32x16 z = {};
#pragma unroll
    for (int s = 0; s < 4; ++s) z = mfma32(kf[s], qf[s], z);
    f32x16 L;
#pragma unroll
    for (int i = 0; i < 16; ++i) { const float az = __builtin_fabsf(z[i]); const float sp = __builtin_fmaxf(z[i], 0.f) + lg2(1.0f + ex2(-az)); L[i] = (CIDX(i) < kq) ? -sp : 0.f; }
#pragma unroll
    for (int i = 6; i >= 0; --i) { L[i] += L[i + 1]; L[8 + i] += L[8 + i + 1]; }
    const float Tlo = L[0], Thi = L[8], Tlo_o = __shfl_xor(Tlo, 32), Thi_o = __shfl_xor(Thi, 32);
    const float off_hi = carry + (h ? 0.f : Thi_o);
    const float off_lo = carry + Thi + Thi_o + (h ? 0.f : Tlo_o);
    carry += (Tlo + Thi) + (Tlo_o + Thi_o);
#pragma unroll
    for (int i = 0; i < 16; ++i) { const float la = z[i] + L[i] + (i < 8 ? off_lo : off_hi); z[i] = (CIDX(i) < kq) ? ex2(la) : 0.f; }
    bf16x8 p0, p1; pack_p(z, p0, p1);
    o0 = mfma32(vf[0][0], p0, o0); o0 = mfma32(vf[0][1], p1, o0);
    o1 = mfma32(vf[1][0], p0, o1); o1 = mfma32(vf[1][1], p1, o1);
}
__device__ __forceinline__ void blk_C(int b, int hd, int chunk, const bf16_t* QK, const bf16_t* VT, bf16_t* mixed, LAS unsigned char* lds, int tid, int lane, int wave) {
    const int q = lane & 31, h = lane >> 5, qb = chunk * 8 + wave;
    const size_t tok0 = (size_t)b * SEQ;
    const bf16_t* Qp = QK + (tok0 + qb * 32 + q) * 2048 + 1536 + hd * 64 + 8 * h;
    bf16x8 qf[4];
#pragma unroll
    for (int s = 0; s < 4; ++s) qf[s] = *(const bf16x8*)(Qp + 16 * s);
    const Stage st = make_stage(tid, QK, VT, tok0, 1792 + hd * 64, 768 + hd * 64);
    LAS unsigned char* sb = lds + SBUF_OFF; volatile LAS unsigned* flags = (volatile LAS unsigned*)(lds + ITEM_OFF) + 16;
    const int sb_end = chunk * 4 + 3;
    int s_iss = sb_end, slot_i = 0, slot_c = 0;
#define ISSUE_DN() do { STG_ISSUE(s_iss > 0 ? s_iss : 0, slot_i); --s_iss; slot_i = slot_i == NSTG - 1 ? 0 : slot_i + 1; } while (0)
    ISSUE_DN(); ISSUE_DN();
    WAITBAR2();
    f32x16 o0 = {}, o1 = {}; float carry = 0.f; bool done = false;
    for (int sbk = sb_end, step = 0; ; --sbk, ++step) {
        const bool more = sbk > 0;
        ISSUE_DN();
        const LAS unsigned char* cb = sb + slot_c * STG_BYTES + lane * 16;
#pragma unroll
        for (int u = 1; u >= 0; --u) { const int kb = 2 * sbk + u;
            if (kb <= qb && !done) { sub_C(cb + u * 8192, qf, (kb == qb) ? q - 8 * h : 64, h, o0, o1, carry); if (__all(carry < -64.0f)) done = true; } }
        if (lane == 0) flags[(step & 1) * 8 + wave] = (more && !done) ? 1u : 0u;
        WAITBAR2();
        slot_c = slot_c == NSTG - 1 ? 0 : slot_c + 1;
        unsigned any = 0;
#pragma unroll
        for (int w = 0; w < 8; ++w) any |= flags[(step & 1) * 8 + w];
        if (!any) break;
    }
    DRAIN_DMA();
    bf16_t* op = mixed + (tok0 + qb * 32 + q) * DM + 768 + hd * 64;
    store_ot(op, o0, 1.0f, h); store_ot(op + 32, o1, 1.0f, h);
}

constexpr int NB_B = NBATCH * 4 * 32, NB_A = NBATCH * 8 * 16, NB_C = NBATCH * 4 * 32, NB_ITEMS = NB_B + NB_A + NB_C;
__device__ __forceinline__ void attn_phase(unsigned char* ws, int layer, LAS unsigned char* lds) {
    int tid_ = threadIdx.x; asm volatile("" : "+v"(tid_));
    const int tid = tid_, lane = tid & 63, wave = __builtin_amdgcn_readfirstlane(tid >> 6);
    const bf16_t* QK = (const bf16_t*)(ws + WS_QK); const bf16_t* VT = (const bf16_t*)(ws + WS_VT); bf16_t* mixed = (bf16_t*)(ws + WS_ACT);
    const float* tblg = (const float*)(ws + WS_TBL); const float* prm = (const float*)(ws + WS_PRM);
#define UNIF(x_) __uint_as_float(__builtin_amdgcn_readfirstlane(__float_as_uint(x_)))
    const float lam = UNIF(prm[PLAM + layer]), osc = UNIF(1.0f - prm[PLAMI + layer]);
    unsigned* ctr = (unsigned*)(ws + WS_CTL) + layer;
    volatile LAS unsigned* ctl = (volatile LAS unsigned*)(lds + ITEM_OFF);
    unsigned nxt = 0; if (tid == 0) nxt = atomicAdd(ctr, 1u);
    for (;;) {
        if (tid == 0) ctl[0] = nxt;
        __syncthreads();
        const int it = __builtin_amdgcn_readfirstlane((int)ctl[0]);
        if (it >= NB_ITEMS) break;
        if (tid == 0) nxt = atomicAdd(ctr, 1u);
        if (it < NB_B) { const int chunk = 31 - (it >> 5), bh = it & 31, b = bh >> 2, hd = bh & 3;
            blk_B(b, hd, chunk, QK, VT, mixed, lds, tblg, UNIF(exp2f(prm[PRB + 31 * 12 + 8 + hd] * LOG2E)), lam, osc, prm + PSUB + layer * 64, tid, lane, wave); }
        else if (it < NB_B + NB_A) { const int j = it - NB_B; const int chunk = 15 - (j >> 6), bh = j & 63, b = bh >> 3, hd = bh & 7;
            blk_A(b, hd, chunk, QK, VT, mixed, lds, tblg, tid, lane, wave); }
        else { const int j = it - NB_B - NB_A; const int chunk = 31 - (j >> 5), bh = j & 31, b = bh >> 2, hd = bh & 3;
            blk_C(b, hd, chunk, QK, VT, mixed, lds, tid, lane, wave); }
    }
}

#define XB_TMO      128
#define XB_XCNT(j)  (256  + 64 * (j))
#define XB_XSUB(j)  (1280 + 64 * (j))
#define XB_XGEN(j)  (2304 + 64 * (j))
#define XB_TOP      3328
#define XB_TOPGEN   3392
#define XCD_BAR_WORDS 3456
#define XB_SPIN_CAP (1u << 18)

__device__ __forceinline__ unsigned xb_ld(unsigned* p)              { return __hip_atomic_load(p, __ATOMIC_RELAXED, __HIP_MEMORY_SCOPE_AGENT); }
__device__ __forceinline__ unsigned xb_add(unsigned* p, unsigned v) { return __hip_atomic_fetch_add(p, v, __ATOMIC_RELAXED, __HIP_MEMORY_SCOPE_AGENT); }
__device__ __forceinline__ unsigned xb_xcc_id() { return (unsigned)__builtin_amdgcn_s_getreg((3 << 11) | 20) & 0xFu; }
#define XB_SPIN(cond, bar) do { unsigned _sp = 0; while (cond) { __builtin_amdgcn_s_sleep(1); \
    if ((++_sp & 255u) == 0u) { if (xb_ld(&(bar)[XB_TMO])) break; if (_sp > XB_SPIN_CAP) { atomicAdd(&(bar)[XB_TMO], 1u); break; } } } } while (0)

struct XcdBarrier {
    unsigned* bar; unsigned x;
    volatile LAS unsigned* st;
};

__device__ __forceinline__ XcdBarrier xcd_barrier_post(unsigned* bar, volatile LAS unsigned* st) {
    XcdBarrier b; b.bar = bar; b.x = xb_xcc_id(); b.st = st;
    if (threadIdx.x == 0) (void)xb_add(&bar[XB_XCNT(b.x)], 1u);
    return b;
}
__device__ __forceinline__ void xcd_barrier_complete(unsigned* bar, unsigned x, unsigned& nloc, unsigned& nx) {
    const unsigned G = gridDim.x * gridDim.y * gridDim.z;
    unsigned sum, cnt, mine, sp = 0u;
    for (;;) {
        sum = 0u; cnt = 0u; mine = 0u;
#pragma unroll
        for (unsigned j = 0; j < 16; ++j) { const unsigned c = xb_ld(&bar[XB_XCNT(j)]); sum += c; cnt += (c > 0u) ? 1u : 0u; mine = (j == x) ? c : mine; }
        if (sum == G) break;
        __builtin_amdgcn_s_sleep(1);
        if ((++sp & 255u) == 0u) { if (xb_ld(&bar[XB_TMO])) break; if (sp > XB_SPIN_CAP) { atomicAdd(&bar[XB_TMO], 1u); break; } }
    }
    nloc = mine > 0u ? mine : 1u; nx = cnt > 0u ? cnt : 1u;
}

__device__ __forceinline__ void xcd_barrier(const XcdBarrier& b) {
    asm volatile("s_waitcnt vmcnt(0)" ::: "memory");
    __syncthreads();
    if (threadIdx.x == 0) {
        unsigned* bar = b.bar;
        __builtin_amdgcn_s_waitcnt(0);
        unsigned nloc = b.st[0], nx = b.st[1];
        if (nloc == 0u) { xcd_barrier_complete(bar, b.x, nloc, nx); b.st[0] = nloc; b.st[1] = nx; }
        const unsigned old = xb_add(&bar[XB_XSUB(b.x)], 1u);
        const unsigned gen = old / nloc;
        if (old + 1u == (gen + 1u) * nloc) {
            __builtin_amdgcn_fence(__ATOMIC_RELEASE, "agent");
            asm volatile("s_waitcnt vmcnt(0)" ::: "memory");
            const unsigned og = xb_add(&bar[XB_TOP], 1u);
            const unsigned tg = og / nx;
            if (og + 1u == (tg + 1u) * nx) xb_add(&bar[XB_TOPGEN], 1u);
            else XB_SPIN(xb_ld(&bar[XB_TOPGEN]) == tg, bar);
            __builtin_amdgcn_fence(__ATOMIC_ACQUIRE, "agent");
            xb_add(&bar[XB_XGEN(b.x)], 1u);
            asm volatile("s_waitcnt vmcnt(0)" ::: "memory");
        } else {
            XB_SPIN(xb_ld(&bar[XB_XGEN(b.x)]) == gen, bar);
            __builtin_amdgcn_fence(__ATOMIC_ACQUIRE, "agent");
            asm volatile("s_waitcnt vmcnt(0)" ::: "memory");
        }
    }
    __syncthreads();
}

constexpr int CW_BAR = 4096;
#define GRID_SYNC() xcd_barrier(xbar)
#ifndef MK_MULTI
#define MK_MULTI 0
#endif
__global__ void __launch_bounds__(512, 2) mega_fwd(Args a) {
    extern __shared__ __attribute__((aligned(16))) unsigned char lds_raw[];
    LAS unsigned char* lds = (LAS unsigned char*)lds_raw;
    cg::grid_group grid = cg::this_grid();
    const int ph_lo = a.ph_lo, ph_hi = a.ph_hi;
    volatile LAS unsigned* xst = (volatile LAS unsigned*)(lds + ITEM_OFF) + 32;
    if (threadIdx.x < 2) xst[threadIdx.x] = 0u;
    __syncthreads();
    const XcdBarrier xbar = xcd_barrier_post((unsigned*)(a.ws + WS_CTL) + CW_BAR, xst);
    if (ph_lo < 0) {
        { const int tid = threadIdx.x; prologue(a, lds, tid, __builtin_amdgcn_readfirstlane(tid >> 6), tid & 63); }
        if (ph_hi > 0) {
            if (ph_hi > 1000000) grid.sync();
            GRID_SYNC();
        }
    }
    unsigned char* const ws = a.ws; float* const out = a.out; const float* const xin = a.x;
    for (int ph = ph_lo < 0 ? 0 : ph_lo; ph < ph_hi; ++ph) {
        const int l = ph / 7, p = ph % 7, G = gridDim.x;
        bf16_t* xb = (bf16_t*)(ws + WS_XB); bf16_t* act = (bf16_t*)(ws + WS_ACT); u64* ss = (u64*)(ws + WS_SS);
        const bf16_t* Wl = (const bf16_t*)(ws + WS_W) + (size_t)l * WROWS * 1024;
        if (p == 0 || p == 5) {
            const pg8::Gemm g{xb, Wl + (size_t)(p == 0 ? WR_GU1 : WR_GU2) * 1024, MTOK, 2048, 1024};
            pg8::StaticOrder S; S.init(MTOK, 2048, G, (int)blockIdx.x, (l * 7 + (p == 0 ? 0 : 5)) & 1);
            const EpiGU E{act, ss + (size_t)(3 * l + (p == 0 ? 0 : 2)) * MTOK};
            pg8::gemm_phase<EpiGU, pg8::StaticOrder, true, true>(lds, g, S, E);
        } else if (p == 1 || p == 4 || p == 6) {
            const int wr = p == 1 ? WR_D1 : (p == 4 ? WR_O : WR_D2);
            const pg8::Gemm g{act, Wl + (size_t)wr * 1024, MTOK, 1024, 1024};
            pg8::StaticOrder S; S.init(MTOK, 1024, G, (int)blockIdx.x, (l * 7 + (p == 1 ? 1 : (p == 4 ? 4 : 6))) & 1);
            u64* ssn = ss + (size_t)(3 * l + (p == 1 ? 1 : (p == 4 ? 2 : 3))) * MTOK; const float alpha = p == 4 ? 1.0f : 0.5f;
            if (ph == 1) { const EpiRes<1> E{xin, out, xb, ssn, alpha}; pg8::gemm_phase<EpiRes<1>, pg8::StaticOrder, true, true>(lds, g, S, E); }
            else if (ph == 7 * DEPTH - 1) { const EpiRes<2> E{xin, out, xb, ssn, alpha}; pg8::gemm_phase<EpiRes<2>, pg8::StaticOrder, true, true>(lds, g, S, E); }
            else { const EpiRes<0> E{xin, out, xb, ssn, alpha}; pg8::gemm_phase<EpiRes<0>, pg8::StaticOrder, true, true>(lds, g, S, E); }
        } else if (p == 2) {
            const float* prm = (const float*)(ws + WS_PRM);
            { const pg8::Gemm g{xb, Wl + (size_t)WR_QK * 1024, MTOK, 2048, 1024};
              pg8::StaticOrder S; S.init(MTOK, 2048, G, (int)blockIdx.x, (l * 7 + 2) & 1);
              const EpiQK E{(bf16_t*)(ws + WS_QK), ss + (size_t)(3 * l + 1) * MTOK, prm + PGN + l * 256};
              pg8::gemm_phase<EpiQK, pg8::StaticOrder, true, true>(lds, g, S, E); }
            { const pg8::Gemm g{Wl + (size_t)WR_V * 1024, xb, 1024, MTOK, 1024};
              pg8::StaticOrder S; S.init(1024, MTOK, G, (int)blockIdx.x, (l * 7 + 3) & 1);
              const EpiVT E{(bf16_t*)(ws + WS_VT), ss + (size_t)(3 * l + 1) * MTOK};
              pg8::gemm_phase<EpiVT, pg8::StaticOrder, true, true>(lds, g, S, E); }
        } else {
            attn_phase(ws, l, lds);
        }
        if (ph + 1 < ph_hi) GRID_SYNC();
    }
}

extern "C" void kernel_launch(void* const* d_in, const int* in_sizes, int n_in, void* d_out, int out_size, void* d_ws, size_t ws_size, hipStream_t stream) {
    static int grid = 0;
    if (grid == 0) {
        if (n_in != 22 || in_sizes[0] != MTOK * DM || out_size != MTOK * DM || ws_size < WS_END) { fprintf(stderr, "kernel_launch: unexpected shapes (n_in %d, in0 %d, out %d, ws %zu)\n", n_in, n_in > 0 ? in_sizes[0] : -1, out_size, ws_size); grid = -1; return; }
        int dev = 0, cus = 0, per_cu = 0;
        (void)hipGetDevice(&dev); (void)hipDeviceGetAttribute(&cus, hipDeviceAttributeMultiprocessorCount, dev);
        (void)hipFuncSetAttribute((const void*)mega_fwd, hipFuncAttributeMaxDynamicSharedMemorySize, LDS_BYTES);
        if (hipOccupancyMaxActiveBlocksPerMultiprocessor(&per_cu, (const void*)mega_fwd, 512, LDS_BYTES) != hipSuccess || per_cu < 1) per_cu = 1;
        (void)hipGetLastError();
        grid = cus * (per_cu > 1 ? 1 : per_cu);
        if (grid <= 0) grid = 256;
    }
    if (grid < 0) return;
    Args a{};
    const float** f = (const float**)&a;
    for (int i = 0; i < 22; ++i) f[i] = (const float*)d_in[i];
    a.out = (float*)d_out; a.ws = (unsigned char*)d_ws;
    (void)hipMemsetAsync((char*)d_ws + WS_CTL, 0, 65536, stream);
    void* args[] = {&a};
#if MK_MULTI
    for (int ph = -1; ph < 7 * DEPTH; ++ph) { a.ph_lo = ph; a.ph_hi = ph + 1;
        hipError_t e = hipLaunchCooperativeKernel((const void*)mega_fwd, dim3(grid), dim3(512), args, LDS_BYTES, stream);
        if (e != hipSuccess) { fprintf(stderr, "launch failed: %s (grid %d)\n", hipGetErrorString(e), grid); break; } }
#else
    a.ph_lo = -1; a.ph_hi = 7 * DEPTH;
    hipError_t e = hipLaunchCooperativeKernel((const void*)mega_fwd, dim3(grid), dim3(512), args, LDS_BYTES, stream);
    if (e != hipSuccess) fprintf(stderr, "cooperative launch failed: %s (grid %d)\n", hipGetErrorString(e), grid);
#endif
}
```

```cpp
#include <hip/hip_runtime.h>
#include <hip/hip_cooperative_groups.h>
#include <cstdio>
#include <cstdint>
namespace cg = cooperative_groups;
namespace pg8 {
#define PG8_LAS __attribute__((address_space(3)))
typedef unsigned short bf16_t;
typedef short bf16x8 __attribute__((ext_vector_type(8)));
typedef float f32x4 __attribute__((ext_vector_type(4)));
typedef unsigned u32x4 __attribute__((ext_vector_type(4)));
constexpr int BM = 256, BK = 64, HALF = 128, HTB = HALF * BK * 2  , STAGE_BYTES = 8 * HTB, NXCD = 8, WGM = 8;

__host__ __device__ __forceinline__ int lds_byte(int r, int c) { const int st = (r >> 4) * 2 + (c >> 5), rr = r & 15, cc = c & 31, ob = rr * 64 + cc * 2; return st * 1024 + (ob ^ (((ob >> 9) & 1) << 5)); }
__host__ __device__ __forceinline__ void stage_rc(int b, int& R, int& C) { const int st = b / 1024, sb = b % 1024, swz = sb ^ (((sb >> 9) & 1) << 5); R = (st >> 1) * 16 + swz / 64; C = (st & 1) * 32 + (swz % 64) / 2; }
__host__ __device__ __forceinline__ int perm32(int rho) { const int n = rho >> 4, i = rho & 15; return 8 * (i >> 2) + 4 * n + (i & 3); }

struct Unit { int pm, pn; };
struct Gemm { const bf16_t* A; const bf16_t* Bt; int M, N, K; };

struct StaticOrder {
    int nM, nN, nwg, G, c, rev;
    __host__ __device__ void init(int M, int N, int G_, int c_, int rev_ = 0) { nM = M / BM; nN = N / BM; nwg = nM * nN; G = G_; c = c_; rev = (rev_ && nwg % G_ == 0) ? 1 : 0; }
    __host__ __device__ bool next(int i, Unit& u) const {
        if (rev) { if (i >= nwg / G) return false; i = nwg / G - 1 - i; }
        const long L = (long)i * G + c; if (L >= nwg) return false;
        int wgid = (int)L; { const int q = nwg / NXCD, r = nwg % NXCD, xcd = wgid % NXCD, off = wgid / NXCD; wgid = (xcd < r ? xcd * (q + 1) : r * (q + 1) + (xcd - r) * q) + off; }
        const int nig = WGM * nN, gid = wgid / nig, fm = gid * WGM, gsz = (nM - fm) < WGM ? (nM - fm) : WGM;
        u.pm = fm + ((wgid % nig) % gsz); u.pn = (wgid % nig) / gsz; return true;
    }
    __device__ __forceinline__ void a_ready(const Unit&) const {}
    __device__ __forceinline__ void done(const Unit&) const {}
};

__device__ __forceinline__ unsigned cvt_pk_bf16(float lo, float hi) { unsigned r; asm volatile("v_cvt_pk_bf16_f32 %0, %1, %2" : "=v"(r) : "v"(lo), "v"(hi)); return r; }
template <class Epi, class Sched, bool ALIGN_EPI = false, bool SP2 = false>
__device__ __forceinline__ void gemm_phase(PG8_LAS unsigned char* lds, const Gemm g, const Sched& S, const Epi& E) {
    int tid_ = threadIdx.x; asm volatile("" : "+v"(tid_));
    const int tid = tid_, wid = __builtin_amdgcn_readfirstlane(tid >> 6), lane = tid & 63, wr = wid >> 2, wc = wid & 3, fr = lane & 15, fq = lane >> 4;
    const int K = g.K, nt = K / BK;
    unsigned voffA[2], voffB[2];
#pragma unroll
    for (int i = 0; i < 2; ++i) { int R, C; stage_rc(tid * 16 + i * 8192, R, C); const int Rb = Epi::PERM ? ((R & ~31) + perm32(R & 31)) : R;
        voffA[i] = (unsigned)(R * K + C) * 2u; voffB[i] = (unsigned)(Rb * K + C) * 2u; }
    const size_t kstep = (size_t)(BK * 2);
    const size_t hstep = (size_t)HALF * K * 2;
    const size_t tstep = 2 * hstep;
    const unsigned ldsw = (unsigned)wid * 1024u;
    const int aoff = lds_byte(wr * 64 + fr, fq * 8), boff = lds_byte(wc * 32 + fr, fq * 8);
#define PG8_SA(b, h) (((b) * 2 + (h)) * HTB)
#define PG8_SB(b, h) ((4 + (b) * 2 + (h)) * HTB)
#define PG8_STAGE(bufoff, gbase, voff) do { _Pragma("unroll") for (int _i = 0; _i < 2; ++_i) \
        __builtin_amdgcn_global_load_lds((const unsigned*)((const char*)(gbase) + (voff)[_i]), (PG8_LAS unsigned*)(lds + (bufoff) + ldsw + _i * 8192), 16, 0, 0); } while (0)
#define PG8_LDA(dst, b, h) do { _Pragma("unroll") for (int m = 0; m < 4; ++m) _Pragma("unroll") for (int k = 0; k < 2; ++k) dst[m][k] = *(const PG8_LAS bf16x8*)(lds + PG8_SA(b, h) + aoff + m * 2048 + k * 1024); } while (0)
#define PG8_LDB(dst, b, h) do { _Pragma("unroll") for (int n = 0; n < 2; ++n) _Pragma("unroll") for (int k = 0; k < 2; ++k) dst[n][k] = *(const PG8_LAS bf16x8*)(lds + PG8_SB(b, h) + boff + n * 2048 + k * 1024); } while (0)
#define PG8_MMA(ai, bj, At, Bt) do { __builtin_amdgcn_s_setprio(1); _Pragma("unroll") for (int m = 0; m < 4; ++m) _Pragma("unroll") for (int n = 0; n < 2; ++n) _Pragma("unroll") for (int k = 0; k < 2; ++k) \
        acc[ai][bj][m][n] = __builtin_amdgcn_mfma_f32_16x16x32_bf16(Bt[n][k], At[m][k], acc[ai][bj][m][n], 0, 0, 0); __builtin_amdgcn_s_setprio(0); } while (0)
#define PG8_WAIT_V(n) asm volatile("s_waitcnt vmcnt(" #n ")" ::: "memory")
#define PG8_WAIT_L(n) asm volatile("s_waitcnt lgkmcnt(" #n ")" ::: "memory")
#define PG8_BAR __builtin_amdgcn_s_barrier()
#define PG8_SCHED __builtin_amdgcn_sched_barrier(0)
    Unit cur, nxt; int ui = 0;
    if (!S.next(0, cur)) return;
    f32x4 acc[2][2][4][2];
#pragma unroll
    for (int a = 0; a < 2; ++a)
#pragma unroll
        for (int b = 0; b < 2; ++b)
#pragma unroll
            for (int m = 0; m < 4; ++m)
#pragma unroll
                for (int n = 0; n < 2; ++n) acc[a][b][m][n] = (f32x4){0.f, 0.f, 0.f, 0.f};
    bf16x8 At[4][2], B0[2][2], B1[2][2];
    const char* cA = (const char*)g.A + (size_t)cur.pm * tstep; const char* cB = (const char*)g.Bt + (size_t)cur.pn * tstep;
    S.a_ready(cur);
    if constexpr (SP2) {
        PG8_STAGE(PG8_SB(0, 0), cB, voffB); PG8_STAGE(PG8_SB(0, 1), cB + hstep, voffB); PG8_STAGE(PG8_SA(0, 0), cA, voffA); PG8_STAGE(PG8_SA(0, 1), cA + hstep, voffA);
        if (wr == 1) PG8_BAR;
        PG8_WAIT_V(2); PG8_BAR;
        PG8_STAGE(PG8_SB(1, 0), cB + kstep, voffB); PG8_STAGE(PG8_SA(1, 0), cA + kstep, voffA); PG8_STAGE(PG8_SB(1, 1), cB + hstep + kstep, voffB);
        PG8_WAIT_V(6); PG8_BAR;
    } else {
        PG8_STAGE(PG8_SB(0, 0), cB, voffB); PG8_STAGE(PG8_SA(0, 0), cA, voffA); PG8_STAGE(PG8_SB(0, 1), cB + hstep, voffB); PG8_STAGE(PG8_SA(0, 1), cA + hstep, voffA);
        if (wr == 1) PG8_BAR;
        PG8_WAIT_V(4); PG8_BAR;
        PG8_STAGE(PG8_SB(1, 0), cB + kstep, voffB); PG8_STAGE(PG8_SA(1, 0), cA + kstep, voffA); PG8_STAGE(PG8_SB(1, 1), cB + hstep + kstep, voffB);
        PG8_WAIT_V(6); PG8_BAR;
    }
    for (;;) {
        const bool has_next = S.next(ui + 1, nxt);
        const char* nA = has_next ? (const char*)g.A + (size_t)nxt.pm * tstep : cA; const char* nB = has_next ? (const char*)g.Bt + (size_t)nxt.pn * tstep : cB;
        for (int t = 0; t < nt; t += 2) {
            const bool last = (t == nt - 2);
            const char* a1 = cA + (size_t)(t + 1) * kstep;
            const char* a2 = last ? nA : cA + (size_t)(t + 2) * kstep; const char* b2 = last ? nB : cB + (size_t)(t + 2) * kstep;
            const char* a3 = a2 + kstep; const char* b3 = b2 + kstep;
            if (last && has_next) S.a_ready(nxt);
            if constexpr (SP2) {
            PG8_LDB(B0, 0, 0); PG8_LDB(B1, 0, 1); PG8_SCHED; PG8_LDA(At, 0, 0); PG8_STAGE(PG8_SA(1, 1), a1 + hstep, voffA);
            PG8_WAIT_V(8); PG8_WAIT_L(0); PG8_BAR; PG8_MMA(0, 0, At, B0); PG8_MMA(0, 1, At, B1); PG8_BAR; PG8_SCHED;
            PG8_LDA(At, 0, 1); PG8_STAGE(PG8_SB(0, 0), b2, voffB); PG8_STAGE(PG8_SB(0, 1), b2 + hstep, voffB); PG8_STAGE(PG8_SA(0, 0), a2, voffA);
            PG8_WAIT_V(8); PG8_WAIT_L(0); PG8_BAR; PG8_MMA(1, 0, At, B0); PG8_MMA(1, 1, At, B1); PG8_BAR; PG8_SCHED;
            PG8_LDB(B0, 1, 0); PG8_LDB(B1, 1, 1); PG8_SCHED; PG8_LDA(At, 1, 0); PG8_STAGE(PG8_SA(0, 1), a2 + hstep, voffA);
            PG8_WAIT_V(8); PG8_WAIT_L(0); PG8_BAR; PG8_MMA(0, 0, At, B0); PG8_MMA(0, 1, At, B1); PG8_BAR; PG8_SCHED;
            PG8_LDA(At, 1, 1); PG8_STAGE(PG8_SB(1, 0), b3, voffB); PG8_STAGE(PG8_SB(1, 1), b3 + hstep, voffB); PG8_STAGE(PG8_SA(1, 0), a3, voffA);
            PG8_WAIT_V(8); PG8_WAIT_L(0); PG8_BAR; PG8_MMA(1, 0, At, B0); PG8_MMA(1, 1, At, B1); PG8_BAR; PG8_SCHED;
            } else {
            PG8_LDB(B0, 0, 0); PG8_SCHED; PG8_LDA(At, 0, 0); PG8_STAGE(PG8_SA(1, 1), a1 + hstep, voffA);
            PG8_WAIT_L(8); PG8_BAR; PG8_WAIT_L(0); PG8_MMA(0, 0, At, B0); PG8_BAR; PG8_SCHED;
            PG8_LDB(B1, 0, 1); PG8_STAGE(PG8_SB(0, 0), b2, voffB);
            PG8_BAR; PG8_WAIT_L(0); PG8_MMA(0, 1, At, B1); PG8_BAR;
            PG8_LDA(At, 0, 1); PG8_STAGE(PG8_SA(0, 0), a2, voffA);
            PG8_BAR; PG8_WAIT_L(0); PG8_MMA(1, 0, At, B0); PG8_BAR; PG8_SCHED;
            PG8_STAGE(PG8_SB(0, 1), b2 + hstep, voffB);
            PG8_WAIT_V(6); PG8_BAR; PG8_MMA(1, 1, At, B1); PG8_BAR;
            PG8_LDB(B0, 1, 0); PG8_SCHED; PG8_LDA(At, 1, 0); PG8_STAGE(PG8_SA(0, 1), a2 + hstep, voffA);
            PG8_WAIT_L(8); PG8_BAR; PG8_WAIT_L(0); PG8_MMA(0, 0, At, B0); PG8_BAR; PG8_SCHED;
            PG8_LDB(B1, 1, 1); PG8_STAGE(PG8_SB(1, 0), b3, voffB);
            PG8_BAR; PG8_WAIT_L(0); PG8_MMA(0, 1, At, B1); PG8_BAR;
            PG8_LDA(At, 1, 1); PG8_STAGE(PG8_SA(1, 0), a3, voffA);
            PG8_BAR; PG8_WAIT_L(0); PG8_MMA(1, 0, At, B0); PG8_BAR; PG8_SCHED;
            PG8_STAGE(PG8_SB(1, 1), b3 + hstep, voffB);
            PG8_WAIT_V(6); PG8_BAR; PG8_MMA(1, 1, At, B1); PG8_BAR;
            }
        }
        if constexpr (ALIGN_EPI) { if (wr == 0) PG8_BAR; }
        if constexpr (!Epi::AFTER_DRAIN) { E(acc, cur, wr, wc, fr, fq); S.done(cur); }
        if (!has_next) break;
#pragma unroll
        for (int a = 0; a < 2; ++a)
#pragma unroll
            for (int b = 0; b < 2; ++b)
#pragma unroll
                for (int m = 0; m < 4; ++m)
#pragma unroll
                    for (int n = 0; n < 2; ++n) acc[a][b][m][n] = (f32x4){0.f, 0.f, 0.f, 0.f};
        cur = nxt; cA = nA; cB = nB; ++ui;
        if constexpr (ALIGN_EPI) { if (wr == 1) PG8_BAR; }
    }
    PG8_WAIT_V(0);
    if constexpr (!ALIGN_EPI) { if (wr == 0) PG8_BAR; }
    PG8_BAR;
    if constexpr (Epi::AFTER_DRAIN) { E.fused(acc, cur, wr, wc, fr, fq, lds, wid, lane); S.done(cur); }
#undef PG8_SA
#undef PG8_SB
#undef PG8_STAGE
#undef PG8_LDA
#undef PG8_LDB
#undef PG8_MMA
#undef PG8_WAIT_V
#undef PG8_WAIT_L
#undef PG8_BAR
#undef PG8_SCHED
}
}
#define LAS __attribute__((address_space(3)))
typedef pg8::bf16_t bf16_t;
typedef pg8::bf16x8 bf16x8;
typedef pg8::f32x4 f32x4;
typedef pg8::u32x4 u32x4;
typedef float f32x16 __attribute__((ext_vector_type(16)));
typedef unsigned u32x2 __attribute__((ext_vector_type(2)));
constexpr int SEQ = 8192, NBATCH = 8, DM = 1024, MTOK = NBATCH * SEQ, DEPTH = 4;
constexpr float EPS = 1e-6f, LOG2E = 1.4426950408889634f;
constexpr int TBLN = 2176, TOFF = 32, TS = 2192;
constexpr int WROWS = 10240;
constexpr int WR_GU1 = 0, WR_D1 = 2048, WR_QK = 3072, WR_V = 5120, WR_O = 6144, WR_GU2 = 7168, WR_D2 = 9216;
constexpr size_t MiB = 1u << 20;
constexpr size_t WS_CTL = 0, WS_SS = 1 * MiB, WS_TBL = 8 * MiB, WS_W = 9 * MiB, WS_XB = 96 * MiB, WS_ACT = 224 * MiB, WS_QK = 352 * MiB, WS_VT = 608 * MiB, WS_END = 736 * MiB;
constexpr size_t WS_PRM = WS_TBL + 512 * 1024;
constexpr int PGN = 0  , PSUB = 1024, PRB = 1280, PLAM = 1664, PLAMI = 1668;
typedef unsigned long long u64;
constexpr float SS_SCALE = 1048576.0f, SS_INV = 1.0f / (1048576.0f * 1024.0f);
__device__ __forceinline__ float row_rs(const u64* ss, int row) { return __builtin_amdgcn_rsqf((float)ss[row] * SS_INV + 1e-6f); }
constexpr int LDS_BYTES = 132096;
constexpr int N_B_ITEMS = NBATCH * 4 * 256, N_A_ITEMS = NBATCH * 8 * 256, N_C_ITEMS = NBATCH * 4 * 256, N_ITEMS = N_B_ITEMS + N_A_ITEMS + N_C_ITEMS;

typedef float f32x2_t __attribute__((ext_vector_type(2))); typedef __bf16 bf16x2_t __attribute__((ext_vector_type(2)));
__device__ __forceinline__ unsigned pkbf(float lo, float hi) { const f32x2_t v = {lo, hi}; const bf16x2_t b = __builtin_convertvector(v, bf16x2_t); return __builtin_bit_cast(unsigned, b); }
__device__ __forceinline__ float wave_sum(float v) {
#pragma unroll
    for (int o = 1; o < 64; o <<= 1) v += __shfl_xor(v, o);
    return v;
}
__device__ __forceinline__ float ex2(float x) { return __builtin_amdgcn_exp2f(x); }
__device__ __forceinline__ float lg2(float x) { return __builtin_amdgcn_logf(x); }

struct EpiGU {
    static constexpr bool PERM = true, AFTER_DRAIN = false;
    bf16_t* O; const u64* ss;
    __device__ __forceinline__ void operator()(const f32x4 (&acc)[2][2][4][2], const pg8::Unit& u, int wr, int wc, int fr, int fq) const {
        const int row0 = u.pm * 256 + wr * 64 + fr, col0 = u.pn * 128 + wc * 32 + 8 * fq;
        u64 sv[2][4];
#pragma unroll
        for (int ai = 0; ai < 2; ++ai)
#pragma unroll
            for (int m = 0; m < 4; ++m) sv[ai][m] = ss[row0 + ai * 128 + m * 16];
#pragma unroll
        for (int ai = 0; ai < 2; ++ai)
#pragma unroll
            for (int m = 0; m < 4; ++m) {
                const int row = row0 + ai * 128 + m * 16;
                const float r = __builtin_amdgcn_rsqf((float)sv[ai][m] * SS_INV + 1e-6f);
                float h[8];
#pragma unroll
                for (int n = 0; n < 2; ++n)
#pragma unroll
                    for (int i = 0; i < 4; ++i) { const float g = acc[ai][0][m][n][i] * r, uu = acc[ai][1][m][n][i] * r;
                        h[n * 4 + i] = g * uu * __builtin_amdgcn_rcpf(1.0f + ex2(-g * LOG2E)); }
                u32x4 w; w.x = pkbf(h[0], h[1]); w.y = pkbf(h[2], h[3]); w.z = pkbf(h[4], h[5]); w.w = pkbf(h[6], h[7]);
                *(u32x4*)(O + (size_t)row * DM + col0) = w;
            }
    }
};
template <int MODE  > struct EpiRes {
    static constexpr bool PERM = true, AFTER_DRAIN = false;
    const float* x32; float* out; bf16_t* xb; u64* ssn; float alpha;
    __device__ __forceinline__ void operator()(const f32x4 (&acc)[2][2][4][2], const pg8::Unit& u, int wr, int wc, int fr, int fq) const {
        const int row0 = u.pm * 256 + wr * 64 + fr, col0 = u.pn * 256 + wc * 32 + 8 * fq;
        float sq[2][4];
        if (MODE == 1) {
#pragma unroll
            for (int ai = 0; ai < 2; ++ai) { f32x4 b[4][2][2];
#pragma unroll
                for (int m = 0; m < 4; ++m)
#pragma unroll
                    for (int bj = 0; bj < 2; ++bj) { const size_t off = (size_t)(row0 + ai * 128 + m * 16) * DM + col0 + bj * 128;
                        b[m][bj][0] = *(const f32x4*)(x32 + off); b[m][bj][1] = *(const f32x4*)(x32 + off + 4); }
#pragma unroll
                for (int m = 0; m < 4; ++m) { float q = 0.f;
#pragma unroll
                    for (int bj = 0; bj < 2; ++bj) q += emit(b[m][bj][0] + acc[ai][bj][m][0] * alpha, b[m][bj][1] + acc[ai][bj][m][1] * alpha, (size_t)(row0 + ai * 128 + m * 16) * DM + col0 + bj * 128);
                    sq[ai][m] = q; } }
        } else {
            u32x4 w[2][4][2];
#pragma unroll
            for (int ai = 0; ai < 2; ++ai)
#pragma unroll
                for (int m = 0; m < 4; ++m)
#pragma unroll
                    for (int bj = 0; bj < 2; ++bj) w[ai][m][bj] = *(const u32x4*)(xb + (size_t)(row0 + ai * 128 + m * 16) * DM + col0 + bj * 128);
#pragma unroll
            for (int ai = 0; ai < 2; ++ai)
#pragma unroll
                for (int m = 0; m < 4; ++m) { float q = 0.f;
#pragma unroll
                    for (int bj = 0; bj < 2; ++bj) { const u32x4 t = w[ai][m][bj];
                        const f32x4 b0 = {__uint_as_float(t.x << 16), __uint_as_float(t.x & 0xffff0000u), __uint_as_float(t.y << 16), __uint_as_float(t.y & 0xffff0000u)};
                        const f32x4 b1 = {__uint_as_float(t.z << 16), __uint_as_float(t.z & 0xffff0000u), __uint_as_float(t.w << 16), __uint_as_float(t.w & 0xffff0000u)};
                        q += emit(b0 + acc[ai][bj][m][0] * alpha, b1 + acc[ai][bj][m][1] * alpha, (size_t)(row0 + ai * 128 + m * 16) * DM + col0 + bj * 128); }
                    sq[ai][m] = q; }
        }
        if (MODE != 2) {
#pragma unroll
            for (int ai = 0; ai < 2; ++ai)
#pragma unroll
                for (int m = 0; m < 4; ++m) sq[ai][m] += __shfl_xor(sq[ai][m], 16);
#pragma unroll
            for (int ai = 0; ai < 2; ++ai)
#pragma unroll
                for (int m = 0; m < 4; ++m) sq[ai][m] += __shfl_xor(sq[ai][m], 32);
            if (fq == 0) {
#pragma unroll
                for (int ai = 0; ai < 2; ++ai)
#pragma unroll
                    for (int m = 0; m < 4; ++m) atomicAdd(ssn + row0 + ai * 128 + m * 16, (u64)(sq[ai][m] * SS_SCALE + 0.5f)); }
        }
    }
    __device__ __forceinline__ float emit(const f32x4 v0, const f32x4 v1, size_t off) const {
        if (MODE == 2) { *(f32x4*)(out + off) = v0; *(f32x4*)(out + off + 4) = v1; return 0.f; }
        u32x4 w; w.x = pkbf(v0[0], v0[1]); w.y = pkbf(v0[2], v0[3]); w.z = pkbf(v1[0], v1[1]); w.w = pkbf(v1[2], v1[3]);
        *(u32x4*)(xb + off) = w;
        return (v0[0] * v0[0] + v0[1] * v0[1]) + (v0[2] * v0[2] + v0[3] * v0[3]) + (v1[0] * v1[0] + v1[1] * v1[1]) + (v1[2] * v1[2] + v1[3] * v1[3]);
    }
};
struct EpiQK {
    static constexpr bool PERM = true, AFTER_DRAIN = false;
    bf16_t* O; const u64* ss; const float* gains;
    __device__ __forceinline__ void operator()(const f32x4 (&acc)[2][2][4][2], const pg8::Unit& u, int wr, int wc, int fr, int fq) const {
        const int pn = u.pn, row0 = u.pm * 256 + wr * 64 + fr, col0 = pn * 256 + wc * 64 + 8 * fq;
        const float* g = gains + (pn < 2 ? 0 : (pn < 4 ? 64 : (pn == 4 ? 128 : (pn == 5 ? 160 : 192))));
        const int gstep = pn < 4 ? 32 : 0;
        const float osc = (pn < 2 || pn == 6) ? 0.125f * LOG2E : (pn == 4 ? 0.17677669529663687f * LOG2E : 1.0f);
        const float inv_n = pn < 4 ? (1.0f / 64.0f) : (1.0f / 32.0f);
        const float* gp = g + 8 * fq;
        u64 sv[2][4];
#pragma unroll
        for (int ai = 0; ai < 2; ++ai)
#pragma unroll
            for (int m = 0; m < 4; ++m) sv[ai][m] = ss[row0 + ai * 128 + m * 16];
        f32x4 gg[2][2];
#pragma unroll
        for (int bj = 0; bj < 2; ++bj) { gg[bj][0] = *(const f32x4*)(gp + bj * gstep); gg[bj][1] = *(const f32x4*)(gp + bj * gstep + 4); }
#pragma unroll
        for (int ai = 0; ai < 2; ++ai)
#pragma unroll
            for (int m = 0; m < 4; ++m) {
                const int row = row0 + ai * 128 + m * 16;
                const float r = __builtin_amdgcn_rsqf((float)sv[ai][m] * SS_INV + 1e-6f);
                float s0, s1;
                { const f32x4 a = acc[ai][0][m][0] * r, b = acc[ai][0][m][1] * r; s0 = (a[0] * a[0] + a[1] * a[1]) + (a[2] * a[2] + a[3] * a[3]) + (b[0] * b[0] + b[1] * b[1]) + (b[2] * b[2] + b[3] * b[3]); }
                { const f32x4 a = acc[ai][1][m][0] * r, b = acc[ai][1][m][1] * r; s1 = (a[0] * a[0] + a[1] * a[1]) + (a[2] * a[2] + a[3] * a[3]) + (b[0] * b[0] + b[1] * b[1]) + (b[2] * b[2] + b[3] * b[3]); }
                if (pn < 4) { s0 += s1; s1 = s0; }
                s0 += __shfl_xor(s0, 16); s1 += __shfl_xor(s1, 16); s0 += __shfl_xor(s0, 32); s1 += __shfl_xor(s1, 32);
                float rn0 = osc * r, rn1 = osc * r;
                if (pn < 6) { rn0 *= __builtin_amdgcn_rsqf(s0 * inv_n + EPS); rn1 *= __builtin_amdgcn_rsqf(s1 * inv_n + EPS); }
#pragma unroll
                for (int bj = 0; bj < 2; ++bj) { const float rn = bj ? rn1 : rn0;
                    const f32x4 y0 = acc[ai][bj][m][0] * gg[bj][0] * rn, y1 = acc[ai][bj][m][1] * gg[bj][1] * rn;
                    u32x4 w; w.x = pkbf(y0[0], y0[1]); w.y = pkbf(y0[2], y0[3]); w.z = pkbf(y1[0], y1[1]); w.w = pkbf(y1[2], y1[3]);
                    *(u32x4*)(O + (size_t)row * 2048 + col0 + 32 * bj) = w; }
            }
    }
};
struct EpiVT {
    static constexpr bool PERM = true, AFTER_DRAIN = false;
    bf16_t* O; const u64* ss;
    __device__ __forceinline__ void operator()(const f32x4 (&acc)[2][2][4][2], const pg8::Unit& u, int wr, int wc, int fr, int fq) const {
        const int row0 = u.pm * 256 + wr * 64 + fr, col0 = u.pn * 256 + wc * 32 + 8 * fq;
        f32x4 r[2][2];
#pragma unroll
        for (int bj = 0; bj < 2; ++bj)
#pragma unroll
            for (int n = 0; n < 2; ++n) {
#pragma unroll
                for (int i = 0; i < 4; ++i) r[bj][n][i] = row_rs(ss, col0 + bj * 128 + 4 * n + i); }
#pragma unroll
        for (int ai = 0; ai < 2; ++ai)
#pragma unroll
            for (int m = 0; m < 4; ++m) {
                const int row = row0 + ai * 128 + m * 16;
#pragma unroll
                for (int bj = 0; bj < 2; ++bj) { const f32x4 y0 = acc[ai][bj][m][0] * r[bj][0], y1 = acc[ai][bj][m][1] * r[bj][1];
                    u32x4 w; w.x = pkbf(y0[0], y0[1]); w.y = pkbf(y0[2], y0[3]); w.z = pkbf(y1[0], y1[1]); w.w = pkbf(y1[2], y1[3]);
                    *(u32x4*)(O + (size_t)row * MTOK + col0 + bj * 128) = w; }
            }
    }
};

struct Args {
    const float *x, *rel_bias, *ffn1_norm, *ffn1_wg, *ffn1_wu, *ffn1_wd, *mix_norm, *w_in, *qna, *kna, *qnb, *knb, *lq1, *lk1, *lq2, *lk2, *subln, *w_out, *ffn2_norm, *ffn2_wg, *ffn2_wu, *ffn2_wd;
    float* out; unsigned char* ws; int ph_lo, ph_hi;
};

struct TrItem { const float* src; const float* gain; bf16_t* dst; int Nsrc, c0, k0; };
__device__ __forceinline__ void tr_load(const TrItem& d, float (&tv)[32], int lane) {
#pragma unroll
    for (int i = 0; i < 32; ++i) tv[i] = d.src[(size_t)(d.k0 + 2 * i + (lane >> 5)) * d.Nsrc + d.c0 + (lane & 31)];
}
__device__ __forceinline__ void tr_store(const TrItem& d, float (&tv)[32], LAS float* scr, int lane) {
    if (d.gain) {
#pragma unroll
        for (int i = 0; i < 32; ++i) tv[i] *= d.gain[d.k0 + 2 * i + (lane >> 5)]; }
#pragma unroll
    for (int i = 0; i < 32; ++i) scr[(2 * i + (lane >> 5)) * 33 + (lane & 31)] = tv[i];
    asm volatile("s_waitcnt lgkmcnt(0)" ::: "memory");
    const int c = lane & 7;
#pragma unroll
    for (int j = 0; j < 4; ++j) { const int n = (lane >> 3) + 8 * j; const LAS float* s = scr + (8 * c) * 33 + n;
        u32x4 o; o.x = pkbf(s[0 * 33], s[1 * 33]); o.y = pkbf(s[2 * 33], s[3 * 33]); o.z = pkbf(s[4 * 33], s[5 * 33]); o.w = pkbf(s[6 * 33], s[7 * 33]);
        *(u32x4*)(d.dst + (size_t)n * 1024 + d.k0 + 8 * c) = o; }
    asm volatile("s_waitcnt lgkmcnt(0)" ::: "memory");
}
__device__ __forceinline__ int t5_bucket(int dist) {
    if (dist < 16) return dist;
    const int large = 16 + (int)(logf((float)dist / 16.0f) / 4.852030263919617f * 16.0f);
    return large < 31 ? large : 31;
}
__device__ __forceinline__ void prologue(const Args& a, LAS unsigned char* lds, int tid, int wave, int lane) {
    const int gw = blockIdx.x * 8 + wave, NGW = gridDim.x * 8;
    unsigned char* ws = a.ws;
    bf16_t* Wb = (bf16_t*)(ws + WS_W);
    LAS float* scr = (LAS float*)(lds + wave * 16384);
#define TR_DECODE(d_, it_) do { const int l = (it_) / 5120, r = (it_) % 5120, rb = r >> 4; (d_).k0 = (r & 15) * 64; (d_).Nsrc = 1024; (d_).gain = nullptr; \
        if (rb < 64 || (rb >= 224 && rb < 288)) { const bool second = rb >= 224; const int n = (second ? rb - 224 : rb) * 32, pn = n >> 8, bj = (n >> 7) & 1, j = n & 127; \
            (d_).src = (second ? (bj ? a.ffn2_wu : a.ffn2_wg) : (bj ? a.ffn1_wu : a.ffn1_wg)) + (size_t)l * 1048576; (d_).c0 = 128 * pn + j; (d_).gain = (second ? a.ffn2_norm : a.ffn1_norm) + l * 1024; } \
        else if (rb < 96) { (d_).src = a.ffn1_wd + (size_t)l * 1048576; (d_).c0 = (rb - 64) * 32; } \
        else if (rb < 160) { const int n = (rb - 96) * 32, pn = n >> 8, bj = (n >> 7) & 1, wc = (n >> 5) & 3, f = 256 * pn + 64 * wc + 32 * bj; \
            (d_).c0 = f < 1024 ? f : (f < 1536 ? 1536 + (f - 1024) : 2304 + (f - 1536)); (d_).src = a.w_in + (size_t)l * 3145728; (d_).Nsrc = 3072; (d_).gain = a.mix_norm + l * 1024; } \
        else if (rb < 192) { const int g = (rb - 160) * 32; (d_).c0 = g < 512 ? 1024 + g : (g < 768 ? 2048 + (g - 512) : 2816 + (g - 768)); (d_).src = a.w_in + (size_t)l * 3145728; (d_).Nsrc = 3072; (d_).gain = a.mix_norm + l * 1024; } \
        else if (rb < 224) { (d_).src = a.w_out + (size_t)l * 1048576; (d_).c0 = (rb - 192) * 32; } \
        else { (d_).src = a.ffn2_wd + (size_t)l * 1048576; (d_).c0 = (rb - 288) * 32; } \
        (d_).dst = Wb + ((size_t)l * WROWS + rb * 32) * 1024; } while (0)
    if (gw < DEPTH * 5120) {
        TrItem cur; float tv[32]; int it = gw; TR_DECODE(cur, it); tr_load(cur, tv, lane);
        for (;;) {
            const int nx = it + NGW; const bool has = nx < DEPTH * 5120; TrItem nxt = cur; float tn[32];
            if (has) { TR_DECODE(nxt, nx); tr_load(nxt, tn, lane); }
            tr_store(cur, tv, scr, lane);
            if (!has) break;
            cur = nxt; it = nx;
#pragma unroll
            for (int i = 0; i < 32; ++i) tv[i] = tn[i];
        }
    }
    bf16_t* xb = (bf16_t*)(ws + WS_XB); u64* ss = (u64*)(ws + WS_SS);
    for (int rb4 = gw * 8; rb4 < MTOK; rb4 += NGW * 8) {
        f32x4 v[8][4]; float sm[8];
#pragma unroll
        for (int r = 0; r < 8; ++r) { const f32x4* xr = (const f32x4*)(a.x + (size_t)(rb4 + r) * DM) + lane;
#pragma unroll
            for (int j = 0; j < 4; ++j) v[r][j] = xr[64 * j]; }
#pragma unroll
        for (int r = 0; r < 8; ++r) { float s = 0.f;
#pragma unroll
            for (int j = 0; j < 4; ++j) s += (v[r][j][0] * v[r][j][0] + v[r][j][1] * v[r][j][1]) + (v[r][j][2] * v[r][j][2] + v[r][j][3] * v[r][j][3]);
            sm[r] = s; }
#pragma unroll
        for (int o = 1; o < 64; o <<= 1) {
#pragma unroll
            for (int r = 0; r < 8; ++r) sm[r] += __shfl_xor(sm[r], o); }
#pragma unroll
        for (int r = 0; r < 8; ++r) { u32x2* o8 = (u32x2*)(xb + (size_t)(rb4 + r) * DM) + lane;
#pragma unroll
            for (int j = 0; j < 4; ++j) { u32x2 w; w.x = pkbf(v[r][j][0], v[r][j][1]); w.y = pkbf(v[r][j][2], v[r][j][3]); o8[64 * j] = w; }
            if (lane == 0) ss[rb4 + r] = (u64)(sm[r] * SS_SCALE + 0.5f); }
    }
    const int gt = blockIdx.x * 512 + tid, NGT = gridDim.x * 512;
    for (int i = gt; i < 12 * MTOK; i += NGT) ss[MTOK + i] = 0ull;
    if (gt < 64) ((unsigned*)(ws + WS_CTL))[gt] = 0u;
    float* prm = (float*)(ws + WS_PRM);
    if (gt < 1024) { const int l = gt >> 8, j = gt & 255;
        prm[PGN + gt] = j < 64 ? a.qna[l * 64 + j] : (j < 128 ? a.kna[l * 64 + j - 64] : (j < 160 ? a.qnb[l * 32 + j - 128] : (j < 192 ? a.knb[l * 32 + j - 160] : 1.0f))); }
    if (gt < 256) prm[PSUB + gt] = a.subln[gt];
    if (gt < 384) prm[PRB + gt] = a.rel_bias[gt];
    if (gt < DEPTH) { float d1 = 0.f, d2 = 0.f;
        for (int i = 0; i < 32; ++i) { d1 += a.lq1[gt * 32 + i] * a.lk1[gt * 32 + i]; d2 += a.lq2[gt * 32 + i] * a.lk2[gt * 32 + i]; }
        const float lam_init = 0.8f - 0.6f * expf(-0.3f * (float)gt);
        prm[PLAM + gt] = expf(d1) - expf(d2) + lam_init; prm[PLAMI + gt] = lam_init; }
    float* tb = (float*)(ws + WS_TBL);
    for (int i = gt; i < 12 * 4 * TS; i += NGT) {
        const int h = i / (4 * TS), xx = (i % TS) + ((i / TS) & 3), dist = (TBLN - 1 - xx) - TOFF;
        float val = -1e30f;
        if (xx < TBLN && dist >= 0) {
            const float bias = a.rel_bias[t5_bucket(dist) * 12 + h] * LOG2E;
            if (h >= 8) val = bias;
            else { const int mult = (dist <= 128 ? 1 : 0) + (((dist & 3) == 0 && dist <= 512) ? 1 : 0) + (((dist & 15) == 0 && dist <= 2048) ? 1 : 0);
                if (mult > 0) val = bias + (mult == 1 ? 0.f : (mult == 2 ? 1.0f : 1.5849625007211562f)); }
        }
        tb[i] = val;
    }
}

__device__ __forceinline__ f32x16 mfma32(bf16x8 a, bf16x8 b, f32x16 c) { return __builtin_amdgcn_mfma_f32_32x32x16_bf16(a, b, c, 0, 0, 0); }
#define CIDX(i) (16 * ((i) >> 3) + ((i) & 7))
__device__ __forceinline__ void pack_p(const f32x16& p, bf16x8& lo, bf16x8& hi) {
    u32x4 a, b; a.x = pkbf(p[0], p[1]); a.y = pkbf(p[2], p[3]); a.z = pkbf(p[4], p[5]); a.w = pkbf(p[6], p[7]);
    b.x = pkbf(p[8], p[9]); b.y = pkbf(p[10], p[11]); b.z = pkbf(p[12], p[13]); b.w = pkbf(p[14], p[15]);
    lo = __builtin_bit_cast(bf16x8, a); hi = __builtin_bit_cast(bf16x8, b);
}
__device__ __forceinline__ void store_ot(bf16_t* dst, const f32x16& o, float sc, int h) {
#pragma unroll
    for (int c = 0; c < 4; ++c) { u32x2 w; w.x = pkbf(o[4 * c] * sc, o[4 * c + 1] * sc); w.y = pkbf(o[4 * c + 2] * sc, o[4 * c + 3] * sc); *(u32x2*)(dst + 8 * c + 4 * h) = w; }
}

constexpr int SBUF_OFF = 4 * TS * 4  , STG_BYTES = 16384, NSTG = 3, ITEM_OFF = 131072  ;
static_assert(ITEM_OFF + 1024 <= LDS_BYTES && SBUF_OFF % 16 == 0 && SBUF_OFF + NSTG * STG_BYTES <= ITEM_OFF, "LDS map");
struct Stage { const bf16_t* ksrc; const bf16_t* vsrc; unsigned kdst, vdst; };
__device__ __forceinline__ Stage make_stage(int tid, const bf16_t* QK, const bf16_t* VT, size_t tok0, int kcol, int vrow) {
    Stage st; const int w = __builtin_amdgcn_readfirstlane(tid >> 6), l = tid & 63, h = l >> 5, r5 = l & 31, pr = (r5 & ~12) | ((r5 & 4) << 1) | ((r5 & 8) >> 1), u = w >> 2;
    st.ksrc = QK + (tok0 + 32 * u + pr) * 2048 + kcol + 16 * (w & 3) + 8 * h; st.kdst = (unsigned)(u * 8192 + (w & 3) * 1024);
    st.vsrc = VT + (size_t)(vrow + 32 * ((w >> 1) & 1) + r5) * MTOK + tok0 + 32 * u + 16 * (w & 1) + 8 * h; st.vdst = (unsigned)(u * 8192 + 4096 + (w & 3) * 1024);
    return st;
}
#define STG_ISSUE(idx_, slot_) do { LAS unsigned char* d_ = sb + (slot_) * STG_BYTES; \
    __builtin_amdgcn_global_load_lds((const unsigned*)(st.ksrc + (size_t)(idx_) * (64 * 2048)), (LAS unsigned*)(d_ + st.kdst), 16, 0, 0); \
    __builtin_amdgcn_global_load_lds((const unsigned*)(st.vsrc + (idx_) * 64), (LAS unsigned*)(d_ + st.vdst), 16, 0, 0); } while (0)
#define WAITBAR2() asm volatile("s_waitcnt vmcnt(2) lgkmcnt(0)\n\ts_barrier" ::: "memory")
#define DRAIN_DMA() asm volatile("s_waitcnt vmcnt(0)" ::: "memory")
#define FRAG_LOAD(cb_) do { LOADK(kf, cb_); LOADV(vf, cb_); } while (0)
#define LOADK(kf_, cb_) do { _Pragma("unroll") for (int s_ = 0; s_ < 4; ++s_) kf_[s_] = *(const LAS bf16x8*)((cb_) + s_ * 1024); } while (0)
#define LOADV(vf_, cb_) do { _Pragma("unroll") for (int d_ = 0; d_ < 2; ++d_) _Pragma("unroll") for (int s_ = 0; s_ < 2; ++s_) vf_[d_][s_] = *(const LAS bf16x8*)((cb_) + 4096 + (d_ * 2 + s_) * 1024); } while (0)
#define LOADT(t_, tp_) do { const f32x4 a_ = *(const LAS f32x4*)(tp_), b_ = *(const LAS f32x4*)((tp_) + 16), c_ = *(const LAS f32x4*)((tp_) + 64), d_ = *(const LAS f32x4*)((tp_) + 80); \
    t_ = (f32x16){a_[0], a_[1], a_[2], a_[3], b_[0], b_[1], b_[2], b_[3], c_[0], c_[1], c_[2], c_[3], d_[0], d_[1], d_[2], d_[3]}; } while (0)
#define LOAD_HEAD_TABLE(hidx_) do { const u32x4* g4_ = (const u32x4*)(tblg + (size_t)(hidx_) * 4 * TS); LAS u32x4* t4_ = (LAS u32x4*)lds; u32x4 v_[5]; \
    _Pragma("unroll") for (int j_ = 0; j_ < 5; ++j_) { const int i_ = j_ * 512 + tid; if (i_ < TS) v_[j_] = g4_[i_]; } \
    _Pragma("unroll") for (int j_ = 0; j_ < 5; ++j_) { const int i_ = j_ * 512 + tid; if (i_ < TS) t4_[i_] = v_[j_]; } } while (0)
#define LANE_TBL() ((const LAS unsigned char*)lds + (((TBLN - 1 - TOFF) - q + 8 * h) & 3) * (TS * 4) + ((((TBLN - 1 - TOFF) - q + 8 * h) & ~3)) * 4)
#define SCHED_FENCE() __builtin_amdgcn_sched_barrier(0)

__device__ __forceinline__ void sm_A(f32x16& sc, float& l, bf16x8& p0, bf16x8& p1) {
#pragma unroll
    for (int i = 0; i < 16; ++i) { const float p = ex2(sc[i]); sc[i] = p; l += p; }
    pack_p(sc, p0, p1);
}
__device__ __forceinline__ void pv4(const bf16x8 (&vf)[2][2], bf16x8 p0, bf16x8 p1, f32x16& o0, f32x16& o1) {
    o0 = mfma32(vf[0][0], p0, o0); o1 = mfma32(vf[1][0], p0, o1); o0 = mfma32(vf[0][1], p1, o0); o1 = mfma32(vf[1][1], p1, o1);
}
__device__ __forceinline__ void sub_A(const bf16x8 (&kf)[4], const bf16x8 (&vf)[2][2], const bf16x8 (&qf)[4], f32x16 sc  , f32x16& o0, f32x16& o1, float& l) {
#pragma unroll
    for (int s = 0; s < 4; ++s) sc = mfma32(kf[s], qf[s], sc);
    bf16x8 p0, p1; sm_A(sc, l, p0, p1);
    pv4(vf, p0, p1, o0, o1);
}
__device__ __forceinline__ void blk_A(int b, int hd, int chunk  , const bf16_t* QK, const bf16_t* VT, bf16_t* mixed, LAS unsigned char* lds, const float* tblg, int tid, int lane, int wave) {
    const int q = lane & 31, h = lane >> 5, qbA = chunk * 16 + wave, qbB = qbA + 8;
    LOAD_HEAD_TABLE(hd);
    const size_t tok0 = (size_t)b * SEQ;
    bf16x8 qfA[4], qfB[4];
    { const bf16_t* Qp = QK + (tok0 + qbA * 32 + q) * 2048 + hd * 64 + 8 * h;
#pragma unroll
      for (int s = 0; s < 4; ++s) { qfA[s] = *(const bf16x8*)(Qp + 16 * s); qfB[s] = *(const bf16x8*)(Qp + (size_t)8 * 32 * 2048 + 16 * s); } }
    const Stage st = make_stage(tid, QK, VT, tok0, 512 + hd * 64, hd * 64);
    LAS unsigned char* sb = lds + SBUF_OFF;
    const int sb_end = chunk * 8 + 7, sb_lo = chunk * 8 > 32 ? chunk * 8 - 32 : 0;
    int s_iss = sb_lo, slot_i = 0, slot_c = 0;
#define ISSUE_UP() do { STG_ISSUE(s_iss < sb_end ? s_iss : sb_end, slot_i); ++s_iss; slot_i = slot_i == NSTG - 1 ? 0 : slot_i + 1; } while (0)
    ISSUE_UP(); ISSUE_UP();
    WAITBAR2();
    f32x16 oA0 = {}, oA1 = {}, oB0 = {}, oB1 = {}; float lA = 0.f, lB = 0.f;
    const LAS unsigned char* tb = LANE_TBL();
    for (int sbk = sb_lo; sbk <= sb_end; ++sbk) {
        ISSUE_UP();
        const LAS unsigned char* cb = sb + slot_c * STG_BYTES + lane * 16;
#pragma unroll
        for (int u = 0; u < 2; ++u) {
            const int kb = 2 * sbk + u; const bool cA = kb <= qbA && kb + 64 >= qbA, cB = kb <= qbB && kb + 64 >= qbB;
            if (cA || cB) {
                bf16x8 kf[4], vf[2][2];
                LOADK(kf, cb + u * 8192); LOADV(vf, cb + u * 8192);
                if (cA) { f32x16 tA; LOADT(tA, tb - (qbA - kb) * 128); SCHED_FENCE(); sub_A(kf, vf, qfA, tA, oA0, oA1, lA); }
                if (cB) { f32x16 tB; LOADT(tB, tb - (qbB - kb) * 128); SCHED_FENCE(); sub_A(kf, vf, qfB, tB, oB0, oB1, lB); }
            }
        }
        WAITBAR2();
        slot_c = slot_c == NSTG - 1 ? 0 : slot_c + 1;
    }
    DRAIN_DMA();
    lA += __shfl_xor(lA, 32); lB += __shfl_xor(lB, 32);
    const float invA = 1.0f / lA, invB = 1.0f / lB;
    bf16_t* op = mixed + (tok0 + qbA * 32 + q) * DM + hd * 64;
    store_ot(op, oA0, invA, h); store_ot(op + 32, oA1, invA, h);
    op += (size_t)8 * 32 * DM;
    store_ot(op, oB0, invB, h); store_ot(op + 32, oB1, invB, h);
}

__device__ __forceinline__ void sub_B(const bf16x8 (&kf)[4], const bf16x8 (&vf)[2][2], const bf16x8 (&qf)[4], const f32x16& t  , f32x16& oa0, f32x16& oa1, f32x16& ob0, f32x16& ob1, float& la, float& lb) {
    f32x16 sa = mfma32(kf[0], qf[0], t); f32x16 sb2 = mfma32(kf[2], qf[2], t); sa = mfma32(kf[1], qf[1], sa); sb2 = mfma32(kf[3], qf[3], sb2);
    SCHED_FENCE();
    bf16x8 pa0, pa1, pb0, pb1;
    sm_A(sa, la, pa0, pa1);
    SCHED_FENCE();
    pv4(vf, pa0, pa1, oa0, oa1);
    SCHED_FENCE();
    sm_A(sb2, lb, pb0, pb1);
    SCHED_FENCE();
    pv4(vf, pb0, pb1, ob0, ob1);
}
#define EXP4(S_, b_) do { S_[b_] = ex2(S_[b_]); S_[(b_) + 1] = ex2(S_[(b_) + 1]); S_[(b_) + 2] = ex2(S_[(b_) + 2]); S_[(b_) + 3] = ex2(S_[(b_) + 3]); } while (0)
#define SUM16(S_, l_) do { l_ += ((S_[0] + S_[1]) + (S_[2] + S_[3])) + ((S_[4] + S_[5]) + (S_[6] + S_[7])) + ((S_[8] + S_[9]) + (S_[10] + S_[11])) + ((S_[12] + S_[13]) + (S_[14] + S_[15])); } while (0)
__device__ __forceinline__ void step_B(const bool FAR, const LAS unsigned char* cb, const LAS unsigned char* tp0, const LAS unsigned char* tp1, const bf16x8 (&qf)[4],
                                       f32x16& oa0, f32x16& oa1, f32x16& ob0, f32x16& ob1, float& la, float& lb) {
    bf16x8 kfA[4], vfA[2][2], kfB[4], vfB[2][2]; f32x16 tA, tB;
    LOADK(kfA, cb); if (!FAR) LOADT(tA, tp0); LOADV(vfA, cb);
    SCHED_FENCE();
    f32x16 S0, S1;
    if (FAR) { S0 = mfma32(kfA[0], qf[0], f32x16{}); S1 = mfma32(kfA[2], qf[2], f32x16{}); }
    else { S0 = mfma32(kfA[0], qf[0], tA); S1 = mfma32(kfA[2], qf[2], tA); }
    S0 = mfma32(kfA[1], qf[1], S0); S1 = mfma32(kfA[3], qf[3], S1);
    kfB[0] = *(const LAS bf16x8*)(cb + 8192); kfB[1] = *(const LAS bf16x8*)(cb + 8192 + 1024); if (!FAR) LOADT(tB, tp1);
    SCHED_FENCE();
    bf16x8 p0, p1, r0, r1;
    f32x16 S2; if (FAR) S2 = mfma32(kfB[0], qf[0], f32x16{}); else S2 = mfma32(kfB[0], qf[0], tB);
    EXP4(S0, 0); EXP4(S0, 4); SCHED_FENCE();
    S2 = mfma32(kfB[1], qf[1], S2); EXP4(S0, 8); EXP4(S0, 12); SCHED_FENCE();
    SUM16(S0, la); pack_p(S0, p0, p1); SCHED_FENCE();
    f32x16 tB2; kfB[2] = *(const LAS bf16x8*)(cb + 8192 + 2048); kfB[3] = *(const LAS bf16x8*)(cb + 8192 + 3072); if (!FAR) LOADT(tB2, tp1);
    oa0 = mfma32(vfA[0][0], p0, oa0); EXP4(S1, 0); SCHED_FENCE();
    oa1 = mfma32(vfA[1][0], p0, oa1); EXP4(S1, 4); SCHED_FENCE();
    oa0 = mfma32(vfA[0][1], p1, oa0); EXP4(S1, 8); SCHED_FENCE();
    oa1 = mfma32(vfA[1][1], p1, oa1); EXP4(S1, 12); SCHED_FENCE();
    f32x16 S3; if (FAR) S3 = mfma32(kfB[2], qf[2], f32x16{}); else S3 = mfma32(kfB[2], qf[2], tB2);
    SUM16(S1, lb); SCHED_FENCE();
    S3 = mfma32(kfB[3], qf[3], S3); pack_p(S1, r0, r1); SCHED_FENCE();
    LOADV(vfB, cb + 8192);
    ob0 = mfma32(vfA[0][0], r0, ob0); EXP4(S2, 0); SCHED_FENCE();
    ob1 = mfma32(vfA[1][0], r0, ob1); EXP4(S2, 4); SCHED_FENCE();
    ob0 = mfma32(vfA[0][1], r1, ob0); EXP4(S2, 8); SCHED_FENCE();
    ob1 = mfma32(vfA[1][1], r1, ob1); EXP4(S2, 12); SCHED_FENCE();
    SUM16(S2, la); pack_p(S2, p0, p1); SCHED_FENCE();
    oa0 = mfma32(vfB[0][0], p0, oa0); EXP4(S3, 0); SCHED_FENCE();
    oa1 = mfma32(vfB[1][0], p0, oa1); EXP4(S3, 4); SCHED_FENCE();
    oa0 = mfma32(vfB[0][1], p1, oa0); EXP4(S3, 8); SCHED_FENCE();
    oa1 = mfma32(vfB[1][1], p1, oa1); EXP4(S3, 12); SCHED_FENCE();
    SUM16(S3, lb); pack_p(S3, r0, r1); SCHED_FENCE();
    ob0 = mfma32(vfB[0][0], r0, ob0); ob1 = mfma32(vfB[1][0], r0, ob1); ob0 = mfma32(vfB[0][1], r1, ob0); ob1 = mfma32(vfB[1][1], r1, ob1);
}
__device__ __forceinline__ void blk_B(int b, int hd, int chunk, const bf16_t* QK, const bf16_t* VT, bf16_t* mixed, LAS unsigned char* lds, const float* tblg, float wfar, float lam, float osc, const float* subln, int tid, int lane, int wave) {
    const int q = lane & 31, h = lane >> 5, qb = chunk * 8 + wave;
    LOAD_HEAD_TABLE(8 + hd);
    const size_t tok0 = (size_t)b * SEQ;
    const bf16_t* Qp = QK + (tok0 + qb * 32 + q) * 2048 + 1024 + hd * 64 + 8 * h;
    bf16x8 qf[4];
#pragma unroll
    for (int s = 0; s < 4; ++s) qf[s] = *(const bf16x8*)(Qp + 16 * s);
    const Stage st = make_stage(tid, QK, VT, tok0, 1280 + hd * 64, 512 + hd * 64);
    LAS unsigned char* sb = lds + SBUF_OFF;
    const int sb_end = chunk * 4 + 3;
    int s_iss = 0, slot_i = 0, slot_c = 0;
    ISSUE_UP(); ISSUE_UP();
    WAITBAR2();
    f32x16 oa0 = {}, oa1 = {}, ob0 = {}, ob1 = {}; float la = 0.f, lb = 0.f; bool scaled = false;
    const LAS unsigned char* tb = LANE_TBL();
    for (int sbk = 0; sbk <= sb_end; ++sbk) {
        ISSUE_UP();
        const LAS unsigned char* cb = sb + slot_c * STG_BYTES + lane * 16;
        const int kb0 = 2 * sbk, kb1 = kb0 + 1; const bool c0 = kb0 <= qb, c1 = kb1 <= qb;
        if (c0 && c1) {
            const bool far = qb - kb1 >= 49;
            if (!far && !scaled) { scaled = true;
#pragma unroll
                for (int i = 0; i < 16; ++i) { oa0[i] *= wfar; oa1[i] *= wfar; ob0[i] *= wfar; ob1[i] *= wfar; }
                la *= wfar; lb *= wfar; }
            const int d0 = qb - kb0 < 64 ? qb - kb0 : 64, d1 = qb - kb1 < 64 ? qb - kb1 : 64;
            step_B(far, cb, tb - d0 * 128, tb - d1 * 128, qf, oa0, oa1, ob0, ob1, la, lb);
        } else if (c0) {
            bf16x8 kfA[4], vfA[2][2]; f32x16 tA;
            const int d0 = qb - kb0 < 64 ? qb - kb0 : 64;
            LOADK(kfA, cb); LOADT(tA, tb - d0 * 128); LOADV(vfA, cb);
            SCHED_FENCE();
            sub_B(kfA, vfA, qf, tA, oa0, oa1, ob0, ob1, la, lb);
        }
        WAITBAR2();
        slot_c = slot_c == NSTG - 1 ? 0 : slot_c + 1;
    }
    DRAIN_DMA();
    la += __shfl_xor(la, 32); lb += __shfl_xor(lb, 32);
    const float ia = 1.0f / la, ib = lam / lb;
    float sq = 0.f;
#pragma unroll
    for (int i = 0; i < 16; ++i) { oa0[i] = oa0[i] * ia - ob0[i] * ib; oa1[i] = oa1[i] * ia - ob1[i] * ib; sq += oa0[i] * oa0[i] + oa1[i] * oa1[i]; }
    sq += __shfl_xor(sq, 32);
    const float rn = __builtin_amdgcn_rsqf(sq * (1.0f / 64.0f) + EPS) * osc;
    bf16_t* op = mixed + (tok0 + qb * 32 + q) * DM + 512 + hd * 64;
#pragma unroll
    for (int c = 0; c < 4; ++c) { const f32x4 g0 = *(const f32x4*)(subln + 8 * c + 4 * h), g1 = *(const f32x4*)(subln + 32 + 8 * c + 4 * h);
        u32x2 w; w.x = pkbf(oa0[4 * c] * rn * g0[0], oa0[4 * c + 1] * rn * g0[1]); w.y = pkbf(oa0[4 * c + 2] * rn * g0[2], oa0[4 * c + 3] * rn * g0[3]); *(u32x2*)(op + 8 * c + 4 * h) = w;
        w.x = pkbf(oa1[4 * c] * rn * g1[0], oa1[4 * c + 1] * rn * g1[1]); w.y = pkbf(oa1[4 * c + 2] * rn * g1[2], oa1[4 * c + 3] * rn * g1[3]); *(u32x2*)(op + 32 + 8 * c + 4 * h) = w; }
}

__device__ __forceinline__ void sub_C(const LAS unsigned char* cb, const bf16x8 (&qf)[4], int kq, int h, f32x16& o0, f32x16& o1, float& carry) {
    bf16x8 kf[4], vf[2][2]; FRAG_LOAD(cb);
    f32x16 z = {};
#pragma unroll
    for (int s = 0; s < 4; ++s) z = mfma32(kf[s], qf[s], z);
    f32x16 L;
#pragma unroll
    for (int i = 0; i < 16; ++i) { const float az = __builtin_fabsf(z[i]); const float sp = __builtin_fmaxf(z[i], 0.f) + lg2(1.0f + ex2(-az)); L[i] = (CIDX(i) < kq) ? -sp : 0.f; }
#pragma unroll
    for (int i = 6; i >= 0; --i) { L[i] += L[i + 1]; L[8 + i] += L[8 + i + 1]; }
    const float Tlo = L[0], Thi = L[8], Tlo_o = __shfl_xor(Tlo, 32), Thi_o = __shfl_xor(Thi, 32);
    const float off_hi = carry + (h ? 0.f : Thi_o);
    const float off_lo = carry + Thi + Thi_o + (h ? 0.f : Tlo_o);
    carry += (Tlo + Thi) + (Tlo_o + Thi_o);
#pragma unroll
    for (int i = 0; i < 16; ++i) { const float la = z[i] + L[i] + (i < 8 ? off_lo : off_hi); z[i] = (CIDX(i) < kq) ? ex2(la) : 0.f; }
    bf16x8 p0, p1; pack_p(z, p0, p1);
    o0 = mfma32(vf[0][0], p0, o0); o0 = mfma32(vf[0][1], p1, o0);
    o1 = mfma32(vf[1][0], p0, o1); o1 = mfma32(vf[1][1], p1, o1);
}
__device__ __forceinline__ void blk_C(int b, int hd, int chunk, const bf16_t* QK, const bf16_t* VT, bf16_t* mixed, LAS unsigned char* lds, int tid, int lane, int wave) {
    const int q = lane & 31, h = lane >> 5, qb = chunk * 8 + wave;
    const size_t tok0 = (size_t)b * SEQ;
    const bf16_t* Qp = QK + (tok0 + qb * 32 + q) * 2048 + 1536 + hd * 64 + 8 * h;
    bf16x8 qf[4];
#pragma unroll
    for (int s = 0; s < 4; ++s) qf[s] = *(const bf16x8*)(Qp + 16 * s);
    const Stage st = make_stage(tid, QK, VT, tok0, 1792 + hd * 64, 768 + hd * 64);
    LAS unsigned char* sb = lds + SBUF_OFF; volatile LAS unsigned* flags = (volatile LAS unsigned*)(lds + ITEM_OFF) + 16;
    const int sb_end = chunk * 4 + 3;
    int s_iss = sb_end, slot_i = 0, slot_c = 0;
#define ISSUE_DN() do { STG_ISSUE(s_iss > 0 ? s_iss : 0, slot_i); --s_iss; slot_i = slot_i == NSTG - 1 ? 0 : slot_i + 1; } while (0)
    ISSUE_DN(); ISSUE_DN();
    WAITBAR2();
    f32x16 o0 = {}, o1 = {}; float carry = 0.f; bool done = false;
    for (int sbk = sb_end, step = 0; ; --sbk, ++step) {
        const bool more = sbk > 0;
        ISSUE_DN();
        const LAS unsigned char* cb = sb + slot_c * STG_BYTES + lane * 16;
#pragma unroll
        for (int u = 1; u >= 0; --u) { const int kb = 2 * sbk + u;
            if (kb <= qb && !done) { sub_C(cb + u * 8192, qf, (kb == qb) ? q - 8 * h : 64, h, o0, o1, carry); if (__all(carry < -64.0f)) done = true; } }
        if (lane == 0) flags[(step & 1) * 8 + wave] = (more && !done) ? 1u : 0u;
        WAITBAR2();
        slot_c = slot_c == NSTG - 1 ? 0 : slot_c + 1;
        unsigned any = 0;
#pragma unroll
        for (int w = 0; w < 8; ++w) any |= flags[(step & 1) * 8 + w];
        if (!any) break;
    }
    DRAIN_DMA();
    bf16_t* op = mixed + (tok0 + qb * 32 + q) * DM + 768 + hd * 64;
    store_ot(op, o0, 1.0f, h); store_ot(op + 32, o1, 1.0f, h);
}

constexpr int NB_B = NBATCH * 4 * 32, NB_A = NBATCH * 8 * 16, NB_C = NBATCH * 4 * 32, NB_ITEMS = NB_B + NB_A + NB_C;
__device__ __forceinline__ void attn_phase(unsigned char* ws, int layer, LAS unsigned char* lds) {
    int tid_ = threadIdx.x; asm volatile("" : "+v"(tid_));
    const int tid = tid_, lane = tid & 63, wave = __builtin_amdgcn_readfirstlane(tid >> 6);
    const bf16_t* QK = (const bf16_t*)(ws + WS_QK); const bf16_t* VT = (const bf16_t*)(ws + WS_VT); bf16_t* mixed = (bf16_t*)(ws + WS_ACT);
    const float* tblg = (const float*)(ws + WS_TBL); const float* prm = (const float*)(ws + WS_PRM);
#define UNIF(x_) __uint_as_float(__builtin_amdgcn_readfirstlane(__float_as_uint(x_)))
    const float lam = UNIF(prm[PLAM + layer]), osc = UNIF(1.0f - prm[PLAMI + layer]);
    unsigned* ctr = (unsigned*)(ws + WS_CTL) + layer;
    volatile LAS unsigned* ctl = (volatile LAS unsigned*)(lds + ITEM_OFF);
    unsigned nxt = 0; if (tid == 0) nxt = atomicAdd(ctr, 1u);
    for (;;) {
        if (tid == 0) ctl[0] = nxt;
        __syncthreads();
        const int it = __builtin_amdgcn_readfirstlane((int)ctl[0]);
        if (it >= NB_ITEMS) break;
        if (tid == 0) nxt = atomicAdd(ctr, 1u);
        if (it < NB_B) { const int chunk = 31 - (it >> 5), bh = it & 31, b = bh >> 2, hd = bh & 3;
            blk_B(b, hd, chunk, QK, VT, mixed, lds, tblg, UNIF(exp2f(prm[PRB + 31 * 12 + 8 + hd] * LOG2E)), lam, osc, prm + PSUB + layer * 64, tid, lane, wave); }
        else if (it < NB_B + NB_A) { const int j = it - NB_B; const int chunk = 15 - (j >> 6), bh = j & 63, b = bh >> 3, hd = bh & 7;
            blk_A(b, hd, chunk, QK, VT, mixed, lds, tblg, tid, lane, wave); }
        else { const int j = it - NB_B - NB_A; const int chunk = 31 - (j >> 5), bh = j & 31, b = bh >> 2, hd = bh & 3;
            blk_C(b, hd, chunk, QK, VT, mixed, lds, tid, lane, wave); }
    }
}

#define XB_TMO      128
#define XB_XCNT(j)  (256  + 64 * (j))
#define XB_XSUB(j)  (1280 + 64 * (j))
#define XB_XGEN(j)  (2304 + 64 * (j))
#define XB_TOP      3328
#define XB_TOPGEN   3392
#define XCD_BAR_WORDS 3456
#define XB_SPIN_CAP (1u << 18)

__device__ __forceinline__ unsigned xb_ld(unsigned* p)              { return __hip_atomic_load(p, __ATOMIC_RELAXED, __HIP_MEMORY_SCOPE_AGENT); }
__device__ __forceinline__ unsigned xb_add(unsigned* p, unsigned v) { return __hip_atomic_fetch_add(p, v, __ATOMIC_RELAXED, __HIP_MEMORY_SCOPE_AGENT); }
__device__ __forceinline__ unsigned xb_xcc_id() { return (unsigned)__builtin_amdgcn_s_getreg((3 << 11) | 20) & 0xFu; }
#define XB_SPIN(cond, bar) do { unsigned _sp = 0; while (cond) { __builtin_amdgcn_s_sleep(1); \
    if ((++_sp & 255u) == 0u) { if (xb_ld(&(bar)[XB_TMO])) break; if (_sp > XB_SPIN_CAP) { atomicAdd(&(bar)[XB_TMO], 1u); break; } } } } while (0)

struct XcdBarrier {
    unsigned* bar; unsigned x;
    volatile LAS unsigned* st;
};

__device__ __forceinline__ XcdBarrier xcd_barrier_post(unsigned* bar, volatile LAS unsigned* st) {
    XcdBarrier b; b.bar = bar; b.x = xb_xcc_id(); b.st = st;
    if (threadIdx.x == 0) (void)xb_add(&bar[XB_XCNT(b.x)], 1u);
    return b;
}
__device__ __forceinline__ void xcd_barrier_complete(unsigned* bar, unsigned x, unsigned& nloc, unsigned& nx) {
    const unsigned G = gridDim.x * gridDim.y * gridDim.z;
    unsigned sum, cnt, mine, sp = 0u;
    for (;;) {
        sum = 0u; cnt = 0u; mine = 0u;
#pragma unroll
        for (unsigned j = 0; j < 16; ++j) { const unsigned c = xb_ld(&bar[XB_XCNT(j)]); sum += c; cnt += (c > 0u) ? 1u : 0u; mine = (j == x) ? c : mine; }
        if (sum == G) break;
        __builtin_amdgcn_s_sleep(1);
        if ((++sp & 255u) == 0u) { if (xb_ld(&bar[XB_TMO])) break; if (sp > XB_SPIN_CAP) { atomicAdd(&bar[XB_TMO], 1u); break; } }
    }
    nloc = mine > 0u ? mine : 1u; nx = cnt > 0u ? cnt : 1u;
}

__device__ __forceinline__ void xcd_barrier(const XcdBarrier& b) {
    asm volatile("s_waitcnt vmcnt(0)" ::: "memory");
    __syncthreads();
    if (threadIdx.x == 0) {
        unsigned* bar = b.bar;
        __builtin_amdgcn_s_waitcnt(0);
        unsigned nloc = b.st[0], nx = b.st[1];
        if (nloc == 0u) { xcd_barrier_complete(bar, b.x, nloc, nx); b.st[0] = nloc; b.st[1] = nx; }
        const unsigned old = xb_add(&bar[XB_XSUB(b.x)], 1u);
        const unsigned gen = old / nloc;
        if (old + 1u == (gen + 1u) * nloc) {
            __builtin_amdgcn_fence(__ATOMIC_RELEASE, "agent");
            asm volatile("s_waitcnt vmcnt(0)" ::: "memory");
            const unsigned og = xb_add(&bar[XB_TOP], 1u);
            const unsigned tg = og / nx;
            if (og + 1u == (tg + 1u) * nx) xb_add(&bar[XB_TOPGEN], 1u);
            else XB_SPIN(xb_ld(&bar[XB_TOPGEN]) == tg, bar);
            __builtin_amdgcn_fence(__ATOMIC_ACQUIRE, "agent");
            xb_add(&bar[XB_XGEN(b.x)], 1u);
            asm volatile("s_waitcnt vmcnt(0)" ::: "memory");
        } else {
            XB_SPIN(xb_ld(&bar[XB_XGEN(b.x)]) == gen, bar);
            __builtin_amdgcn_fence(__ATOMIC_ACQUIRE, "agent");
            asm volatile("s_waitcnt vmcnt(0)" ::: "memory");
        }
    }
    __syncthreads();
}

constexpr int CW_BAR = 4096;
#define GRID_SYNC() xcd_barrier(xbar)
#ifndef MK_MULTI
#define MK_MULTI 0
#endif
__global__ void __launch_bounds__(512, 2) mega_fwd(Args a) {
    extern __shared__ __attribute__((aligned(16))) unsigned char lds_raw[];
    LAS unsigned char* lds = (LAS unsigned char*)lds_raw;
    cg::grid_group grid = cg::this_grid();
    const int ph_lo = a.ph_lo, ph_hi = a.ph_hi;
    volatile LAS unsigned* xst = (volatile LAS unsigned*)(lds + ITEM_OFF) + 32;
    if (threadIdx.x < 2) xst[threadIdx.x] = 0u;
    __syncthreads();
    const XcdBarrier xbar = xcd_barrier_post((unsigned*)(a.ws + WS_CTL) + CW_BAR, xst);
    if (ph_lo < 0) {
        { const int tid = threadIdx.x; prologue(a, lds, tid, __builtin_amdgcn_readfirstlane(tid >> 6), tid & 63); }
        if (ph_hi > 0) { asm volatile("s_waitcnt vmcnt(0) lgkmcnt(0)" ::: "memory"); grid.sync();
            if (threadIdx.x < 64) { __builtin_amdgcn_fence(__ATOMIC_ACQUIRE, "agent"); asm volatile("s_waitcnt vmcnt(0)" ::: "memory"); } __syncthreads(); }
    }
    unsigned char* const ws = a.ws; float* const out = a.out; const float* const xin = a.x;
    for (int ph = ph_lo < 0 ? 0 : ph_lo; ph < ph_hi; ++ph) {
        const int l = ph / 7, p = ph % 7, G = gridDim.x;
        bf16_t* xb = (bf16_t*)(ws + WS_XB); bf16_t* act = (bf16_t*)(ws + WS_ACT); u64* ss = (u64*)(ws + WS_SS);
        const bf16_t* Wl = (const bf16_t*)(ws + WS_W) + (size_t)l * WROWS * 1024;
        if (p == 0 || p == 5) {
            const pg8::Gemm g{xb, Wl + (size_t)(p == 0 ? WR_GU1 : WR_GU2) * 1024, MTOK, 2048, 1024};
            pg8::StaticOrder S; S.init(MTOK, 2048, G, (int)blockIdx.x, (l * 7 + (p == 0 ? 0 : 5)) & 1);
            const EpiGU E{act, ss + (size_t)(3 * l + (p == 0 ? 0 : 2)) * MTOK};
            pg8::gemm_phase<EpiGU, pg8::StaticOrder, true, true>(lds, g, S, E);
        } else if (p == 1 || p == 4 || p == 6) {
            const int wr = p == 1 ? WR_D1 : (p == 4 ? WR_O : WR_D2);
            const pg8::Gemm g{act, Wl + (size_t)wr * 1024, MTOK, 1024, 1024};
            pg8::StaticOrder S; S.init(MTOK, 1024, G, (int)blockIdx.x, (l * 7 + (p == 1 ? 1 : (p == 4 ? 4 : 6))) & 1);
            u64* ssn = ss + (size_t)(3 * l + (p == 1 ? 1 : (p == 4 ? 2 : 3))) * MTOK; const float alpha = p == 4 ? 1.0f : 0.5f;
            if (ph == 1) { const EpiRes<1> E{xin, out, xb, ssn, alpha}; pg8::gemm_phase<EpiRes<1>, pg8::StaticOrder, true, true>(lds, g, S, E); }
            else if (ph == 7 * DEPTH - 1) { const EpiRes<2> E{xin, out, xb, ssn, alpha}; pg8::gemm_phase<EpiRes<2>, pg8::StaticOrder, true, true>(lds, g, S, E); }
            else { const EpiRes<0> E{xin, out, xb, ssn, alpha}; pg8::gemm_phase<EpiRes<0>, pg8::StaticOrder, true, true>(lds, g, S, E); }
        } else if (p == 2) {
            const float* prm = (const float*)(ws + WS_PRM);
            { const pg8::Gemm g{xb, Wl + (size_t)WR_QK * 1024, MTOK, 2048, 1024};
              pg8::StaticOrder S; S.init(MTOK, 2048, G, (int)blockIdx.x, (l * 7 + 2) & 1);
              const EpiQK E{(bf16_t*)(ws + WS_QK), ss + (size_t)(3 * l + 1) * MTOK, prm + PGN + l * 256};
              pg8::gemm_phase<EpiQK, pg8::StaticOrder, true, true>(lds, g, S, E); }
            { const pg8::Gemm g{Wl + (size_t)WR_V * 1024, xb, 1024, MTOK, 1024};
              pg8::StaticOrder S; S.init(1024, MTOK, G, (int)blockIdx.x, (l * 7 + 3) & 1);
              const EpiVT E{(bf16_t*)(ws + WS_VT), ss + (size_t)(3 * l + 1) * MTOK};
              pg8::gemm_phase<EpiVT, pg8::StaticOrder, true, true>(lds, g, S, E); }
        } else {
            attn_phase(ws, l, lds);
        }
        if (ph + 1 < ph_hi) GRID_SYNC();
    }
}

extern "C" void kernel_launch(void* const* d_in, const int* in_sizes, int n_in, void* d_out, int out_size, void* d_ws, size_t ws_size, hipStream_t stream) {
    static int grid = 0;
    if (grid == 0) {
        if (n_in != 22 || in_sizes[0] != MTOK * DM || out_size != MTOK * DM || ws_size < WS_END) { fprintf(stderr, "kernel_launch: unexpected shapes (n_in %d, in0 %d, out %d, ws %zu)\n", n_in, n_in > 0 ? in_sizes[0] : -1, out_size, ws_size); grid = -1; return; }
        int dev = 0, cus = 0, per_cu = 0;
        (void)hipGetDevice(&dev); (void)hipDeviceGetAttribute(&cus, hipDeviceAttributeMultiprocessorCount, dev);
        (void)hipFuncSetAttribute((const void*)mega_fwd, hipFuncAttributeMaxDynamicSharedMemorySize, LDS_BYTES);
        if (hipOccupancyMaxActiveBlocksPerMultiprocessor(&per_cu, (const void*)mega_fwd, 512, LDS_BYTES) != hipSuccess || per_cu < 1) per_cu = 1;
        (void)hipGetLastError();
        grid = cus * (per_cu > 1 ? 1 : per_cu);
        if (grid <= 0) grid = 256;
    }
    if (grid < 0) return;
    Args a{};
    const float** f = (const float**)&a;
    for (int i = 0; i < 22; ++i) f[i] = (const float*)d_in[i];
    a.out = (float*)d_out; a.ws = (unsigned char*)d_ws;
    (void)hipMemsetAsync((char*)d_ws + WS_CTL, 0, 65536, stream);
    void* args[] = {&a};
#if MK_MULTI
    for (int ph = -1; ph < 7 * DEPTH; ++ph) { a.ph_lo = ph; a.ph_hi = ph + 1;
        hipError_t e = hipLaunchCooperativeKernel((const void*)mega_fwd, dim3(grid), dim3(512), args, LDS_BYTES, stream);
        if (e != hipSuccess) { fprintf(stderr, "launch failed: %s (grid %d)\n", hipGetErrorString(e), grid); break; } }
#else
    a.ph_lo = -1; a.ph_hi = 7 * DEPTH;
    hipError_t e = hipLaunchCooperativeKernel((const void*)mega_fwd, dim3(grid), dim3(512), args, LDS_BYTES, stream);
    if (e != hipSuccess) fprintf(stderr, "cooperative launch failed: %s (grid %d)\n", hipGetErrorString(e), grid);
#endif
}
```
